# Optimizing an MI355X kernel written in HIP

```python
import math
import jax, jax.numpy as jnp
from jax import lax
import numpy as np

D_MODEL = 1024
BATCH = 16
SEQ = 4096
DEPTH = 1
DEC_BATCH = 8
DEC_SEQ = 64
PAST_LEN = 1024

CHUNK = 64
QBLOCK = 128
ROPE_THETA = 500000.0
RMS_EPS = 1e-6
DA_HEADS = 4
DA_QK_DIM = 64
DA_V_DIM = 2 * DA_QK_DIM
DA_WIDTH = DA_HEADS * DA_V_DIM
DA_ROT = DA_QK_DIM // 4
DA_QK_COLS = DA_HEADS * 2 * DA_QK_DIM
MLA_HEADS = 8
MLA_Q_LORA = 384
MLA_KV_LORA = 256
MLA_NOPE = 64
MLA_ROPE = 32
MLA_V_DIM = 64
MLA_WIDTH = MLA_HEADS * MLA_V_DIM
MLA_UQ_COLS = MLA_HEADS * (MLA_NOPE + MLA_ROPE)
IN_SIZES = (DA_QK_COLS, DA_QK_COLS, DA_WIDTH, DA_WIDTH, MLA_Q_LORA, MLA_KV_LORA, MLA_ROPE, MLA_WIDTH, 2 * D_MODEL)
IN_COLS = sum(IN_SIZES)

kernel_name = "hybrid_diffattn_mla_streaming_step"


def rms_norm(x, g):
    xf = x.astype(jnp.float32)
    y = xf * lax.rsqrt(jnp.mean(xf * xf, axis=-1, keepdims=True) + RMS_EPS)
    return (y * g.astype(jnp.float32)).astype(x.dtype)


def rope(x, pos, rot):
    half = rot // 2
    inv = jnp.float32(ROPE_THETA) ** (-jnp.arange(half, dtype=jnp.float32) * 2.0 / rot)
    ang = pos.astype(jnp.float32)[:, None] * inv
    ang = ang.reshape((ang.shape[0],) + (1,) * (x.ndim - 3) + (half,))
    cos = jnp.cos(ang).astype(x.dtype)
    sin = jnp.sin(ang).astype(x.dtype)
    x1 = x[..., :half]
    x2 = x[..., half:rot]
    return jnp.concatenate([x1 * cos - x2 * sin, x2 * cos + x1 * sin, x[..., rot:]], axis=-1)


def chunk_mask(q_pos, k_pos):
    return (k_pos // CHUNK)[None, :] <= (q_pos // CHUNK)[:, None]


def masked_softmax(s, mask):
    return jax.nn.softmax(jnp.where(mask, s.astype(jnp.float32), -jnp.inf), axis=-1)


def over_query_blocks(fn, qs, q_pos):
    S = q_pos.shape[0]
    if S <= QBLOCK:
        return fn(qs, q_pos)
    nb = S // QBLOCK

    def body(i):
        start = i * QBLOCK
        qb = tuple(lax.dynamic_slice_in_dim(q, start, QBLOCK, axis=1) for q in qs)
        pb = lax.dynamic_slice_in_dim(q_pos, start, QBLOCK)
        return fn(qb, pb)

    out = lax.map(body, jnp.arange(nb))
    out = jnp.moveaxis(out, 0, 1)
    return out.reshape((out.shape[0], S) + out.shape[3:])


def diff_attention(q, k, v, q_pos, k_pos, lam):
    scale = DA_QK_DIM ** -0.5

    def fn(qs, qp):
        (qb,) = qs
        s = jnp.einsum('bqhcd,bkhcd->bchqk', qb, k) * scale
        p = masked_softmax(s, chunk_mask(qp, k_pos))
        a = (p[:, 0] - lam * p[:, 1]).astype(v.dtype)
        return jnp.einsum('bhqk,bkhd->bqhd', a, v)

    return over_query_blocks(fn, (q,), q_pos)


def mla_attention(q, k, v, q_pos, k_pos):
    scale = (MLA_NOPE + MLA_ROPE) ** -0.5

    def fn(qs, qp):
        (qb,) = qs
        s = jnp.einsum('bqhd,bkhd->bhqk', qb, k) * scale
        p = masked_softmax(s, chunk_mask(qp, k_pos)).astype(v.dtype)
        return jnp.einsum('bhqk,bkhd->bqhd', p, v)

    return over_query_blocks(fn, (q,), q_pos)


def layer(x, past, lam_init, norm_g, w_in, gate_b, da_lambda, da_head_norm_g, mla_q_norm_g,
          mla_kv_norm_g, mla_w_uq, mla_w_uk, mla_w_uv, w_branch_a, w_branch_b, w_out):
    B, S, _ = x.shape
    past_len = 0 if past is None else past[0].shape[1]
    pos = past_len + jnp.arange(S, dtype=jnp.int32)
    k_pos = jnp.arange(past_len + S, dtype=jnp.int32)

    h = rms_norm(x, norm_g)
    proj = h @ w_in
    idx = np.cumsum(IN_SIZES)[:-1].tolist()
    da_q, da_k, da_v, da_z, cq, ckv, krope, mla_z, gates = jnp.split(proj, idx, axis=-1)

    q = rope(da_q.reshape(B, S, DA_HEADS, 2, DA_QK_DIM), pos, DA_ROT)
    k = rope(da_k.reshape(B, S, DA_HEADS, 2, DA_QK_DIM), pos, DA_ROT)
    v = da_v.reshape(B, S, DA_HEADS, DA_V_DIM)
    new_k = k.reshape(B, S, DA_HEADS, 2 * DA_QK_DIM)
    new_v = v
    c_kv = rms_norm(ckv, mla_kv_norm_g)
    k_r = rope(krope, pos, MLA_ROPE)

    if past is None:
        k_all, v_all, c_all, kr_all = k, v, c_kv, k_r
    else:
        pk, pv, pc, pr = past
        k_all = jnp.concatenate([pk.reshape(B, past_len, DA_HEADS, 2, DA_QK_DIM), k], axis=1)
        v_all = jnp.concatenate([pv, v], axis=1)
        c_all = jnp.concatenate([pc, c_kv], axis=1)
        kr_all = jnp.concatenate([pr, k_r], axis=1)
    T = past_len + S

    lf = da_lambda.astype(jnp.float32)
    lam = jnp.exp(jnp.sum(lf[0] * lf[1])) - jnp.exp(jnp.sum(lf[2] * lf[3])) + lam_init
    o_a = diff_attention(q, k_all, v_all, pos, k_pos, lam)
    o_a = (rms_norm(o_a, da_head_norm_g) * (1.0 - lam_init)).reshape(B, S, DA_WIDTH)

    qf = (rms_norm(cq, mla_q_norm_g) @ mla_w_uq).reshape(B, S, MLA_HEADS, MLA_NOPE + MLA_ROPE)
    q_m = jnp.concatenate([qf[..., :MLA_NOPE], rope(qf[..., MLA_NOPE:], pos, MLA_ROPE)], axis=-1)
    k_nope = (c_all @ mla_w_uk).reshape(B, T, MLA_HEADS, MLA_NOPE)
    v_m = (c_all @ mla_w_uv).reshape(B, T, MLA_HEADS, MLA_V_DIM)
    k_m = jnp.concatenate([k_nope, jnp.broadcast_to(kr_all[:, :, None, :], (B, T, MLA_HEADS, MLA_ROPE))], axis=-1)
    o_b = mla_attention(q_m, k_m, v_m, pos, k_pos).reshape(B, S, MLA_WIDTH)

    y_a = (o_a * jax.nn.silu(da_z)) @ w_branch_a
    y_b = (o_b * jax.nn.silu(mla_z)) @ w_branch_b
    g = jax.nn.sigmoid(gates + gate_b)
    m = g[..., :D_MODEL] * y_a + g[..., D_MODEL:] * y_b
    out = x + m @ w_out
    return out, (new_k, new_v, c_kv, k_r)


def setup_inputs(seed: int = 0) -> dict:
    key = jax.random.key(seed)
    ks = jax.random.split(key, 24)
    nrm = lambda k, shape, s: jax.random.normal(k, shape, jnp.float32) * s
    return {
        'x_prompt': nrm(ks[0], (BATCH, SEQ, D_MODEL), 1.0),
        'x_sample': nrm(ks[1], (DEC_BATCH, DEC_SEQ, D_MODEL), 1.0),
        'cache_da_k': nrm(ks[2], (DEPTH, DEC_BATCH, PAST_LEN, DA_HEADS, 2 * DA_QK_DIM), 1.0),
        'cache_da_v': nrm(ks[3], (DEPTH, DEC_BATCH, PAST_LEN, DA_HEADS, DA_V_DIM), 1.0),
        'cache_mla_latent': nrm(ks[4], (DEPTH, DEC_BATCH, PAST_LEN, MLA_KV_LORA), 1.0),
        'cache_mla_krope': nrm(ks[5], (DEPTH, DEC_BATCH, PAST_LEN, MLA_ROPE), 1.0),
        'norm_g': 1.0 + nrm(ks[6], (DEPTH, D_MODEL), 0.01),
        'w_in': nrm(ks[7], (DEPTH, D_MODEL, IN_COLS), D_MODEL ** -0.5),
        'gate_b': nrm(ks[8], (DEPTH, 2 * D_MODEL), 0.01),
        'da_lambda': nrm(ks[9], (DEPTH, 4, DA_QK_DIM), 0.1),
        'da_head_norm_g': 1.0 + nrm(ks[10], (DEPTH, DA_V_DIM), 0.01),
        'mla_q_norm_g': 1.0 + nrm(ks[11], (DEPTH, MLA_Q_LORA), 0.01),
        'mla_kv_norm_g': 1.0 + nrm(ks[12], (DEPTH, MLA_KV_LORA), 0.01),
        'mla_w_uq': nrm(ks[13], (DEPTH, MLA_Q_LORA, MLA_UQ_COLS), MLA_Q_LORA ** -0.5),
        'mla_w_uk': nrm(ks[14], (DEPTH, MLA_KV_LORA, MLA_HEADS * MLA_NOPE), MLA_KV_LORA ** -0.5),
        'mla_w_uv': nrm(ks[15], (DEPTH, MLA_KV_LORA, MLA_WIDTH), MLA_KV_LORA ** -0.5),
        'w_branch_a': nrm(ks[16], (DEPTH, DA_WIDTH, D_MODEL), DA_WIDTH ** -0.5),
        'w_branch_b': nrm(ks[17], (DEPTH, MLA_WIDTH, D_MODEL), MLA_WIDTH ** -0.5),
        'w_out': nrm(ks[18], (DEPTH, D_MODEL, D_MODEL), D_MODEL ** -0.5),
        'final_norm_g': 1.0 + nrm(ks[19], (D_MODEL,), 0.01),
    }


def reference(x_prompt, x_sample, cache_da_k, cache_da_v, cache_mla_latent, cache_mla_krope,
              norm_g, w_in, gate_b, da_lambda, da_head_norm_g, mla_q_norm_g, mla_kv_norm_g,
              mla_w_uq, mla_w_uk, mla_w_uv, w_branch_a, w_branch_b, w_out, final_norm_g):
    hp, hs = x_prompt, x_sample
    rows_p = ([], [], [], [])
    rows_s = ([], [], [], [])
    for l in range(DEPTH):
        lam_init = 0.8 - 0.6 * math.exp(-0.3 * l)
        w = (norm_g[l], w_in[l], gate_b[l], da_lambda[l], da_head_norm_g[l], mla_q_norm_g[l],
             mla_kv_norm_g[l], mla_w_uq[l], mla_w_uk[l], mla_w_uv[l], w_branch_a[l], w_branch_b[l], w_out[l])
        hp, new_p = layer(hp, None, lam_init, *w)
        past = (cache_da_k[l], cache_da_v[l], cache_mla_latent[l], cache_mla_krope[l])
        hs, new_s = layer(hs, past, lam_init, *w)
        for acc, r in zip(rows_p, new_p):
            acc.append(r)
        for acc, r in zip(rows_s, new_s):
            acc.append(r)
    y_prompt = rms_norm(hp, final_norm_g)
    y_sample = rms_norm(hs, final_norm_g)
    new_da_k_p = jnp.stack(rows_p[0], 0)
    new_da_v_p = jnp.stack(rows_p[1], 0)
    new_lat_p = jnp.stack(rows_p[2], 0)
    new_krope_p = jnp.stack(rows_p[3], 0)
    new_da_k_s = jnp.stack(rows_s[0], 0)
    new_da_v_s = jnp.stack(rows_s[1], 0)
    new_lat_s = jnp.stack(rows_s[2], 0)
    new_krope_s = jnp.stack(rows_s[3], 0)
    return (y_prompt, y_sample, new_da_k_p, new_da_v_p, new_lat_p, new_krope_p,
            new_da_k_s, new_da_v_s, new_lat_s, new_krope_s)
```

```cpp
#include <hip/hip_runtime.h>
#include <hip/hip_cooperative_groups.h>
#include <cstdio>
#include <cstdint>
namespace cg = cooperative_groups;

#ifndef MK_N_LAUNCHES
#define MK_N_LAUNCHES 1
#endif

#define LAS __attribute__((address_space(3)))
typedef unsigned short bf16_t;
typedef short bf16x8 __attribute__((ext_vector_type(8)));
typedef short s16x4 __attribute__((ext_vector_type(4)));
typedef float f32x2 __attribute__((ext_vector_type(2)));
typedef float f32x4 __attribute__((ext_vector_type(4)));
typedef float f32x16 __attribute__((ext_vector_type(16)));
typedef unsigned u32x2 __attribute__((ext_vector_type(2)));
typedef unsigned u32x4 __attribute__((ext_vector_type(4)));
typedef __bf16 bf16x2_t __attribute__((ext_vector_type(2)));

constexpr int DM = 1024, NB = 16, SEQ = 4096, DECB = 8, DECS = 64, PAST = 1024;
constexpr int MP = NB * SEQ;
constexpr int MS = DECB * DECS;
constexpr int MT = MP + MS;
constexpr int TS = PAST + DECS;
constexpr int KR = MP + DECB * TS;
constexpr int NIN = 5376;
constexpr float RMS_EPS = 1e-6f;
constexpr float LOG2E = 1.4426950408889634f;
constexpr float C2A = 0.125f * LOG2E;
constexpr float C2M = 0.10206207261596575f * LOG2E;
constexpr float LAM_INIT = 0.2f;
constexpr size_t O_Y = 0;
constexpr size_t O_KP = (size_t)MT * 1024;
constexpr size_t O_VP = O_KP + (size_t)MP * 512;
constexpr size_t O_LP = O_VP + (size_t)MP * 512;
constexpr size_t O_RP = O_LP + (size_t)MP * 256;
constexpr size_t O_KS = O_RP + (size_t)MP * 32;
constexpr size_t O_VS = O_KS + (size_t)MS * 512;
constexpr size_t O_LS = O_VS + (size_t)MS * 512;
constexpr size_t O_RS = O_LS + (size_t)MS * 256;
constexpr size_t O_END = O_RS + (size_t)MS * 32;
constexpr size_t MiB = 1u << 20;
constexpr size_t WS_CTL = 0, WS_LAM = 4096, WS_ROPE_DA = 8192, WS_ROPE_ML = WS_ROPE_DA + 4096 * 8 * 8;
constexpr size_t WS_WIN = 1 * MiB, WS_WUQ = 12 * MiB, WS_WUKV = 13 * MiB, WS_WA = 14 * MiB, WS_WB = 15 * MiB, WS_WOUT = 16 * MiB;
constexpr size_t WS_SSQ = 18 * MiB, WS_SSKV = 23 * MiB, WS_SSY = 26 * MiB;
constexpr size_t WS_XN = 36 * MiB;
constexpr size_t WS_UA = WS_XN, WS_UB = WS_XN + (size_t)MT * 512 * 2;
constexpr size_t WS_QA = 166 * MiB, WS_KA = 231 * MiB, WS_VA = 304 * MiB, WS_SZA = 377 * MiB;
constexpr size_t WS_T = WS_QA;
constexpr size_t WS_SZB = 442 * MiB, WS_CQ = 507 * MiB, WS_CALL = 556 * MiB, WS_KR = 593 * MiB;
constexpr size_t WS_QM = 598 * MiB, WS_KN = 695 * MiB, WS_VM = 768 * MiB;
constexpr size_t WS_MM = WS_QM;
constexpr size_t WS_END = 841 * MiB;
static_assert(WS_XN + (size_t)MT * 1024 * 2 <= WS_QA && WS_T + (size_t)MT * 1024 * 4 <= WS_SZB && WS_MM + (size_t)MT * 1024 * 2 <= WS_VM + (size_t)KR * 512 * 2, "ws map");
static_assert(WS_QA + (size_t)MT * 512 * 2 <= WS_KA && WS_KA + (size_t)KR * 512 * 2 <= WS_VA && WS_VA + (size_t)KR * 512 * 2 <= WS_SZA && WS_SZA + (size_t)MT * 512 * 2 <= WS_SZB, "ws map 2");
static_assert(WS_SZB + (size_t)MT * 512 * 2 <= WS_CQ && WS_CQ + (size_t)MT * 384 * 2 <= WS_CALL && WS_CALL + (size_t)KR * 256 * 2 <= WS_KR && WS_KR + (size_t)KR * 32 * 2 <= WS_QM, "ws map 3");
static_assert(WS_QM + (size_t)MT * 768 * 2 <= WS_KN && WS_KN + (size_t)KR * 512 * 2 <= WS_VM && WS_VM + (size_t)KR * 512 * 2 <= WS_END, "ws map 4");
static_assert(WS_WIN + (size_t)NIN * 1024 * 2 <= WS_WUQ && WS_SSQ + (size_t)MT * 16 * 4 <= WS_SSKV && WS_SSKV + (size_t)MT * 8 * 4 <= WS_SSY && WS_SSY + (size_t)MT * 32 * 4 <= WS_XN, "ws map 5");

constexpr int NTHREADS = 512, NWAVES = 8;
constexpr int LDS_BYTES = 139264;
constexpr int LDS_MISC = 135168;

__constant__ float c_inv_da[8] = {1.0f, 0.1939227432012558f, 0.03760603070259094f, 0.007292664609849453f, 0.0014142135623842478f, 0.00027424818836152554f, 5.318296098266728e-05f, 1.0313386155758053e-05f};
__constant__ float c_inv_ml[16] = {1.0f, 0.44036659598350525f, 0.1939227432012558f, 0.08539710193872452f, 0.03760603070259094f, 0.01656043902039528f, 0.007292664609849453f, 0.0032114458736032248f,
                                   0.0014142135623842478f, 0.000622772378847003f, 0.00027424818836152554f, 0.00012076973507646471f, 5.318296098266728e-05f, 2.34199997066753e-05f, 1.0313386155758053e-05f, 4.541670477919979e-06f};

__device__ __forceinline__ unsigned pk2(float lo, float hi) { f32x2 v = {lo, hi}; bf16x2_t b = __builtin_convertvector(v, bf16x2_t); return __builtin_bit_cast(unsigned, b); }
__device__ __forceinline__ float bflo(unsigned u) { return __builtin_bit_cast(float, u << 16); }
__device__ __forceinline__ float bfhi(unsigned u) { return __builtin_bit_cast(float, u & 0xffff0000u); }
__device__ __forceinline__ float bf2f(bf16_t h) { return __builtin_bit_cast(float, (unsigned)h << 16); }
__device__ __forceinline__ u32x4 pack8(const float* v) { u32x4 w; w.x = pk2(v[0], v[1]); w.y = pk2(v[2], v[3]); w.z = pk2(v[4], v[5]); w.w = pk2(v[6], v[7]); return w; }
__device__ __forceinline__ void unpack8(u32x4 w, float* v) { v[0] = bflo(w.x); v[1] = bfhi(w.x); v[2] = bflo(w.y); v[3] = bfhi(w.y); v[4] = bflo(w.z); v[5] = bfhi(w.z); v[6] = bflo(w.w); v[7] = bfhi(w.w); }
__device__ __forceinline__ int tok_pos(int row) { return row < MP ? (row & (SEQ - 1)) : PAST + ((row - MP) & (DECS - 1)); }
__device__ __forceinline__ int tok_krow(int row) { return row < MP ? row : MP + ((row - MP) >> 6) * TS + PAST + ((row - MP) & 63); }
__device__ __forceinline__ float wave_sum(float v) {
#pragma unroll
    for (int o = 1; o < 64; o <<= 1) v += __shfl_xor(v, o);
    return v;
}
__device__ __forceinline__ float sigmoidf_(float x) { return 1.0f / (1.0f + __expf(-x)); }
__device__ __forceinline__ float siluf_(float x) { return x / (1.0f + __expf(-x)); }
__device__ __forceinline__ int crow(int r, int hi) { return (r & 3) + 8 * (r >> 2) + 4 * hi; }
__host__ __device__ __forceinline__ int perm32(int rho) { const int n = rho >> 4, i = rho & 15; return 8 * (i >> 2) + 4 * n + (i & 3); }

struct Args {
    const float* in[20]; float* out; unsigned char* ws; int ph_lo, ph_hi;
};

struct Unit { int pm, pn, src; };
constexpr int G_LDA = 144;
template <class Epi>
__device__ __forceinline__ void gemm_tile(LAS unsigned char* lds, const bf16_t* __restrict__ A, const bf16_t* __restrict__ Bt, int K, const Unit u, const Epi& E) {
    const int tid = threadIdx.x, wid = __builtin_amdgcn_readfirstlane(tid >> 6), lane = tid & 63, wr = wid >> 2, wc = wid & 3, fr = lane & 15, fq = lane >> 4;
    f32x4 acc[2][2][4][2];
#pragma unroll
    for (int a = 0; a < 2; ++a)
#pragma unroll
        for (int b = 0; b < 2; ++b)
#pragma unroll
            for (int m = 0; m < 4; ++m)
#pragma unroll
                for (int n = 0; n < 2; ++n) acc[a][b][m][n] = (f32x4){0.f, 0.f, 0.f, 0.f};
    const int nt = K / 64;
    LAS unsigned char* As = lds; LAS unsigned char* Bs = lds + 256 * G_LDA;
    const int srow = tid >> 3, sch = tid & 7;
    const bf16_t* ap = A + (size_t)(u.pm * 256 + srow) * K + sch * 8;
    const bf16_t* bp = Bt + (size_t)(u.pn * 256 + (srow & ~31) + perm32(srow & 31)) * K + sch * 8;
    const int lo = srow * G_LDA + sch * 16;
    for (int kt = 0; kt < nt; ++kt) {
        u32x4 ra[4], rb[4];
#pragma unroll
        for (int i = 0; i < 4; ++i) { ra[i] = *(const u32x4*)(ap + (size_t)(64 * i) * K + kt * 64); rb[i] = *(const u32x4*)(bp + (size_t)(64 * i) * K + kt * 64); }
        __syncthreads();
#pragma unroll
        for (int i = 0; i < 4; ++i) { *(LAS u32x4*)(As + lo + 64 * i * G_LDA) = ra[i]; *(LAS u32x4*)(Bs + lo + 64 * i * G_LDA) = rb[i]; }
        __syncthreads();
#pragma unroll
        for (int k = 0; k < 2; ++k)
#pragma unroll
            for (int ai = 0; ai < 2; ++ai) {
                bf16x8 At[4];
#pragma unroll
                for (int m = 0; m < 4; ++m) At[m] = *(const LAS bf16x8*)(As + (128 * ai + 64 * wr + 16 * m + fr) * G_LDA + k * 64 + fq * 16);
#pragma unroll
                for (int bj = 0; bj < 2; ++bj) {
                    bf16x8 Bf[2];
#pragma unroll
                    for (int n = 0; n < 2; ++n) Bf[n] = *(const LAS bf16x8*)(Bs + (128 * bj + 32 * wc + 16 * n + fr) * G_LDA + k * 64 + fq * 16);
#pragma unroll
                    for (int m = 0; m < 4; ++m)
#pragma unroll
                        for (int n = 0; n < 2; ++n) acc[ai][bj][m][n] = __builtin_amdgcn_mfma_f32_16x16x32_bf16(Bf[n], At[m], acc[ai][bj][m][n], 0, 0, 0);
                }
            }
    }
    E(acc, u, wr, wc, fr, fq);
}

#define EPI_ROWS_BEGIN \
    _Pragma("unroll") for (int ai = 0; ai < 2; ++ai) _Pragma("unroll") for (int m = 0; m < 4; ++m) { const int row = u.pm * 256 + ai * 128 + wr * 64 + m * 16 + fr;
#define EPI_COLS_BEGIN \
    _Pragma("unroll") for (int bj = 0; bj < 2; ++bj) { const int c8 = u.pn * 256 + bj * 128 + wc * 32 + fq * 8; float v[8]; \
        v[0] = acc[ai][bj][m][0][0]; v[1] = acc[ai][bj][m][0][1]; v[2] = acc[ai][bj][m][0][2]; v[3] = acc[ai][bj][m][0][3]; \
        v[4] = acc[ai][bj][m][1][0]; v[5] = acc[ai][bj][m][1][1]; v[6] = acc[ai][bj][m][1][2]; v[7] = acc[ai][bj][m][1][3];
#define EPI_END } }

__device__ __forceinline__ void st8f(float* p, const float* v) { *(f32x4*)p = (f32x4){v[0], v[1], v[2], v[3]}; *(f32x4*)(p + 4) = (f32x4){v[4], v[5], v[6], v[7]}; }
__device__ __forceinline__ void ld8f(const float* p, float* v) { const f32x4 a = *(const f32x4*)p, b = *(const f32x4*)(p + 4); v[0] = a[0]; v[1] = a[1]; v[2] = a[2]; v[3] = a[3]; v[4] = b[0]; v[5] = b[1]; v[6] = b[2]; v[7] = b[3]; }
template <int XM> __device__ __forceinline__ void rope8(float* v, bool active, bool first, const f32x2* cs) {
    float pr[8];
#pragma unroll
    for (int j = 0; j < 8; ++j) pr[j] = __shfl_xor(v[j], XM);
    if (active) {
#pragma unroll
        for (int j = 0; j < 8; ++j) { const f32x2 c = cs[j]; v[j] = first ? v[j] * c.x - pr[j] * c.y : v[j] * c.x + pr[j] * c.y; }
    }
}

struct Epi1 {
    bf16_t *QA, *KA, *VA, *SZA, *SZB, *G, *CQ, *CALL, *KRB; float *SSQ, *SSKV, *out;
    const float *gate_b, *gq, *gkv; const f32x2 *cs_da, *cs_ml;
    __device__ __forceinline__ void operator()(const f32x4 (&acc)[2][2][4][2], const Unit& u, int wr, int wc, int fr, int fq) const {
        const int pn = u.pn;
        if (pn < 2) {
            EPI_ROWS_BEGIN const int pos = tok_pos(row);
            EPI_COLS_BEGIN
                if ((wc & 1) == 0) rope8<16>(v, fq < 2, fq == 0, cs_da + pos * 8);
#pragma unroll
                for (int j = 0; j < 8; ++j) v[j] *= C2A;
                *(u32x4*)(QA + (size_t)row * 512 + c8) = pack8(v);
            EPI_END
        } else if (pn < 4) {
            EPI_ROWS_BEGIN const int pos = tok_pos(row); const int kr = tok_krow(row);
                float* orow = row < MP ? out + O_KP + (size_t)row * 512 : out + O_KS + (size_t)(row - MP) * 512;
            EPI_COLS_BEGIN const int c = c8 - 512;
                if ((wc & 1) == 0) rope8<16>(v, fq < 2, fq == 0, cs_da + pos * 8);
                st8f(orow + c, v);
                *(u32x4*)(KA + (size_t)kr * 512 + c) = pack8(v);
            EPI_END
        } else if (pn < 6) {
            EPI_ROWS_BEGIN const int kr = tok_krow(row);
                float* orow = row < MP ? out + O_VP + (size_t)row * 512 : out + O_VS + (size_t)(row - MP) * 512;
            EPI_COLS_BEGIN const int c = c8 - 1024;
                st8f(orow + c, v);
                *(u32x4*)(VA + (size_t)kr * 512 + c) = pack8(v);
            EPI_END
        } else if (pn < 10) {
            bf16_t* dst = pn < 8 ? SZA : SZB; const int cb = pn < 8 ? 1536 : 2048;
            EPI_ROWS_BEGIN
            EPI_COLS_BEGIN const int c = c8 - cb;
#pragma unroll
                for (int j = 0; j < 8; ++j) v[j] = siluf_(v[j]);
                *(u32x4*)(dst + (size_t)row * 512 + c) = pack8(v);
            EPI_END
        } else if (pn < 18) {
            EPI_ROWS_BEGIN
            EPI_COLS_BEGIN const int c = c8 - 2560; float b[8]; ld8f(gate_b + c, b);
#pragma unroll
                for (int j = 0; j < 8; ++j) v[j] = sigmoidf_(v[j] + b[j]);
                *(u32x4*)(G + (size_t)row * 2048 + c) = pack8(v);
            EPI_END
        } else if (pn == 20) {
            EPI_ROWS_BEGIN const int kr = tok_krow(row);
                float* orow = row < MP ? out + O_LP + (size_t)row * 256 : out + O_LS + (size_t)(row - MP) * 256;
            EPI_COLS_BEGIN const int c = c8 - 5120; float g[8]; ld8f(gkv + c, g); float ss = 0.f;
#pragma unroll
                for (int j = 0; j < 8; ++j) { ss += v[j] * v[j]; v[j] *= g[j]; }
                ss += __shfl_xor(ss, 16); ss += __shfl_xor(ss, 32);
                if (fq == 0) SSKV[(size_t)row * 8 + bj * 4 + wc] = ss;
                st8f(orow + c, v);
                *(u32x4*)(CALL + (size_t)kr * 256 + c) = pack8(v);
            EPI_END
        } else {
            EPI_ROWS_BEGIN const int pos = tok_pos(row); const int kr = tok_krow(row);
            EPI_COLS_BEGIN
                if (pn == 18 || bj == 0) {
                    const int c = c8 - 4608; float g[8]; ld8f(gq + c, g); float ss = 0.f;
#pragma unroll
                    for (int j = 0; j < 8; ++j) { ss += v[j] * v[j]; v[j] *= g[j]; }
                    ss += __shfl_xor(ss, 16); ss += __shfl_xor(ss, 32);
                    if (fq == 0) SSQ[(size_t)row * 16 + (pn - 18) * 8 + bj * 4 + wc] = ss;
                    *(u32x4*)(CQ + (size_t)row * 384 + c) = pack8(v);
                } else if (wc == 0) {
                    const int c = fq * 8;
                    rope8<32>(v, true, fq < 2, cs_ml + pos * 16 + (fq & 1) * 8);
                    float* orow = row < MP ? out + O_RP + (size_t)row * 32 : out + O_RS + (size_t)(row - MP) * 32;
                    st8f(orow + c, v);
                    *(u32x4*)(KRB + (size_t)kr * 32 + c) = pack8(v);
                }
            EPI_END
        }
    }
};
struct Epi2a {
    bf16_t* QM; const float* SSQ; const f32x2* cs_ml;
    __device__ __forceinline__ void operator()(const f32x4 (&acc)[2][2][4][2], const Unit& u, int wr, int wc, int fr, int fq) const {
        EPI_ROWS_BEGIN const int pos = tok_pos(row);
            float s = 0.f; { const f32x4* p = (const f32x4*)(SSQ + (size_t)row * 16); const f32x4 a = p[0], b = p[1], c = p[2]; s = (a[0] + a[1] + a[2] + a[3]) + (b[0] + b[1] + b[2] + b[3]) + (c[0] + c[1] + c[2] + c[3]); }
            const float sc = rsqrtf(s * (1.0f / 384.0f) + RMS_EPS) * C2M;
        EPI_COLS_BEGIN
            const int g32 = u.pn * 8 + bj * 4 + wc;
#pragma unroll
            for (int j = 0; j < 8; ++j) v[j] *= sc;
            if (g32 % 3 == 2) rope8<32>(v, true, fq < 2, cs_ml + pos * 16 + (fq & 1) * 8);
            *(u32x4*)(QM + (size_t)row * 768 + c8) = pack8(v);
        EPI_END
    }
};
struct Epi2b {
    bf16_t *KN, *VM; const float* SSKV;
    __device__ __forceinline__ void operator()(const f32x4 (&acc)[2][2][4][2], const Unit& u, int wr, int wc, int fr, int fq) const {
        EPI_ROWS_BEGIN
            int trow = row; bool isnew = true;
            if (row >= MP) { const int s = row - MP, b = s / TS, t = s - b * TS; isnew = t >= PAST; trow = MP + b * 64 + (t - PAST); }
            float sc = 1.0f;
            if (isnew) { const f32x4* p = (const f32x4*)(SSKV + (size_t)trow * 8); const f32x4 a = p[0], b = p[1]; sc = rsqrtf(((a[0] + a[1] + a[2] + a[3]) + (b[0] + b[1] + b[2] + b[3])) * (1.0f / 256.0f) + RMS_EPS); }
        EPI_COLS_BEGIN
#pragma unroll
            for (int j = 0; j < 8; ++j) v[j] *= sc;
            if (u.pn < 2) *(u32x4*)(KN + (size_t)row * 512 + c8) = pack8(v);
            else *(u32x4*)(VM + (size_t)row * 512 + (c8 - 512)) = pack8(v);
        EPI_END
    }
};
struct Epi3a {
    float* T; const bf16_t* G;
    __device__ __forceinline__ void operator()(const f32x4 (&acc)[2][2][4][2], const Unit& u, int wr, int wc, int fr, int fq) const {
        EPI_ROWS_BEGIN
        EPI_COLS_BEGIN float g[8]; unpack8(*(const u32x4*)(G + (size_t)row * 2048 + c8), g);
#pragma unroll
            for (int j = 0; j < 8; ++j) v[j] *= g[j];
            st8f(T + (size_t)row * 1024 + c8, v);
        EPI_END
    }
};
struct Epi3b {
    const float* T; const bf16_t* G; bf16_t* MM;
    __device__ __forceinline__ void operator()(const f32x4 (&acc)[2][2][4][2], const Unit& u, int wr, int wc, int fr, int fq) const {
        EPI_ROWS_BEGIN
        EPI_COLS_BEGIN float g[8], t[8]; unpack8(*(const u32x4*)(G + (size_t)row * 2048 + 1024 + c8), g); ld8f(T + (size_t)row * 1024 + c8, t);
#pragma unroll
            for (int j = 0; j < 8; ++j) v[j] = t[j] + v[j] * g[j];
            *(u32x4*)(MM + (size_t)row * 1024 + c8) = pack8(v);
        EPI_END
    }
};
struct Epi4 {
    const float *xp, *xs; float* Y; float* SSY;
    __device__ __forceinline__ void operator()(const f32x4 (&acc)[2][2][4][2], const Unit& u, int wr, int wc, int fr, int fq) const {
        EPI_ROWS_BEGIN const float* xr = row < MP ? xp + (size_t)row * 1024 : xs + (size_t)(row - MP) * 1024;
        EPI_COLS_BEGIN float x[8]; ld8f(xr + c8, x); float ss = 0.f;
#pragma unroll
            for (int j = 0; j < 8; ++j) { v[j] += x[j]; ss += v[j] * v[j]; }
            ss += __shfl_xor(ss, 16); ss += __shfl_xor(ss, 32);
            if (fq == 0) SSY[(size_t)row * 32 + u.pn * 8 + bj * 4 + wc] = ss;
            st8f(Y + (size_t)row * 1024 + c8, v);
        EPI_END
    }
};

__device__ __forceinline__ int win_dst(int n) {
    if (n < 2048) return n;
    if (n < 2432) return n - 2048 + 4608;
    if (n < 2688) return n - 2432 + 5120;
    if (n < 2720) return n - 2688 + 4992;
    if (n < 3232) return n - 2720 + 2048;
    return n - 3232 + 2560;
}
__device__ __forceinline__ void transpose_item(const float* __restrict__ W, int K, int N, bf16_t* WT, int k0, int n0, int drow0, LAS float* scr, int lane) {
#pragma unroll 8
    for (int i = 0; i < 32; ++i) { const int kk = 2 * i + (lane >> 5); scr[kk * 33 + (lane & 31)] = W[(size_t)(k0 + kk) * N + n0 + (lane & 31)]; }
    asm volatile("s_waitcnt lgkmcnt(0)" ::: "memory");
    const int c = lane & 7;
#pragma unroll
    for (int j = 0; j < 4; ++j) { const int n = (lane >> 3) + 8 * j; const LAS float* s = scr + (8 * c) * 33 + n;
        u32x4 o; o.x = pk2(s[0 * 33], s[1 * 33]); o.y = pk2(s[2 * 33], s[3 * 33]); o.z = pk2(s[4 * 33], s[5 * 33]); o.w = pk2(s[6 * 33], s[7 * 33]);
        *(u32x4*)(WT + (size_t)(drow0 + n) * K + k0 + 8 * c) = o; }
    asm volatile("s_waitcnt lgkmcnt(0)" ::: "memory");
}
__device__ __forceinline__ void sincos_acc(float angf, float& c, float& s) {
    const double x = (double)angf; const double n = __builtin_rint(x * 0.63661977236758134308);
    const double r = __builtin_fma(-n, 1.5707963267948966192, x) - n * 6.123233995736766e-17; const double r2 = r * r;
    double sp = -1.0 / 1307674368000.0; sp = sp * r2 + 1.0 / 6227020800.0; sp = sp * r2 - 1.0 / 39916800.0; sp = sp * r2 + 1.0 / 362880.0; sp = sp * r2 - 1.0 / 5040.0; sp = sp * r2 + 1.0 / 120.0; sp = sp * r2 - 1.0 / 6.0; sp = sp * r2 + 1.0; sp *= r;
    double cp = 1.0 / 20922789888000.0; cp = cp * r2 - 1.0 / 87178291200.0; cp = cp * r2 + 1.0 / 479001600.0; cp = cp * r2 - 1.0 / 3628800.0; cp = cp * r2 + 1.0 / 40320.0; cp = cp * r2 - 1.0 / 720.0; cp = cp * r2 + 1.0 / 24.0; cp = cp * r2 - 0.5; cp = cp * r2 + 1.0;
    const int q = ((int)n) & 3;
    const double ss = (q == 0) ? sp : (q == 1) ? cp : (q == 2) ? -sp : -cp;
    const double cc = (q == 0) ? cp : (q == 1) ? -sp : (q == 2) ? -cp : sp;
    c = (float)cc; s = (float)ss;
}
__device__ __forceinline__ void p0_prologue(const Args& a, LAS unsigned char* lds) {
    const int tid = threadIdx.x, lane = tid & 63, wave = tid >> 6;
    const int G = gridDim.x, gw = blockIdx.x * NWAVES + wave, NGW = G * NWAVES, gt = blockIdx.x * NTHREADS + tid, NGT = G * NTHREADS;
    unsigned char* ws = a.ws;
    LAS float* scr = (LAS float*)(lds + wave * 8704);
    if (blockIdx.x == 0 && wave == 0) {
        if (lane < 16) ((unsigned*)(ws + WS_CTL))[lane] = 0u;
        const float* L = a.in[9];
        const float sa = wave_sum(L[lane] * L[64 + lane]), sb = wave_sum(L[128 + lane] * L[192 + lane]);
        if (lane == 0) ((float*)(ws + WS_LAM))[0] = expf(sa) - expf(sb) + LAM_INIT;
    }
    for (int i = gt; i < 4096 * 8; i += NGT) { const int pos = i >> 3, j = i & 7; float c, s; sincos_acc((float)pos * c_inv_da[j], c, s); ((f32x2*)(ws + WS_ROPE_DA))[i] = (f32x2){c, s}; }
    for (int i = gt; i < 4096 * 16; i += NGT) { const int pos = i >> 4, j = i & 15; float c, s; sincos_acc((float)pos * c_inv_ml[j], c, s); ((f32x2*)(ws + WS_ROPE_ML))[i] = (f32x2){c, s}; }
    constexpr int I_IN = 16 * 165, I_UQ = 6 * 24, I_UK = 4 * 16, I_UV = 4 * 16, I_A = 8 * 32, I_B = 8 * 32, I_O = 16 * 32;
    constexpr int NITEMS = I_IN + I_UQ + I_UK + I_UV + I_A + I_B + I_O;
    for (int it = gw; it < NITEMS; it += NGW) {
        int r = it;
        if (r < I_IN) { const int kb = r / 165, nb = r % 165; transpose_item(a.in[7], 1024, 5280, (bf16_t*)(ws + WS_WIN), kb * 64, nb * 32, win_dst(nb * 32), scr, lane); continue; } r -= I_IN;
        if (r < I_UQ) { const int kb = r / 24, nb = r % 24; transpose_item(a.in[13], 384, 768, (bf16_t*)(ws + WS_WUQ), kb * 64, nb * 32, nb * 32, scr, lane); continue; } r -= I_UQ;
        if (r < I_UK) { const int kb = r / 16, nb = r % 16; transpose_item(a.in[14], 256, 512, (bf16_t*)(ws + WS_WUKV), kb * 64, nb * 32, nb * 32, scr, lane); continue; } r -= I_UK;
        if (r < I_UV) { const int kb = r / 16, nb = r % 16; transpose_item(a.in[15], 256, 512, (bf16_t*)(ws + WS_WUKV), kb * 64, nb * 32, 512 + nb * 32, scr, lane); continue; } r -= I_UV;
        if (r < I_A) { const int kb = r / 32, nb = r % 32; transpose_item(a.in[16], 512, 1024, (bf16_t*)(ws + WS_WA), kb * 64, nb * 32, nb * 32, scr, lane); continue; } r -= I_A;
        if (r < I_B) { const int kb = r / 32, nb = r % 32; transpose_item(a.in[17], 512, 1024, (bf16_t*)(ws + WS_WB), kb * 64, nb * 32, nb * 32, scr, lane); continue; } r -= I_B;
        { const int kb = r / 32, nb = r % 32; transpose_item(a.in[18], 1024, 1024, (bf16_t*)(ws + WS_WOUT), kb * 64, nb * 32, nb * 32, scr, lane); }
    }
    { u32x4* z = (u32x4*)((bf16_t*)(ws + WS_WIN) + (size_t)5024 * 1024); for (int i = gt; i < 96 * 1024 / 8; i += NGT) z[i] = (u32x4){0u, 0u, 0u, 0u}; }
    {
        const float* gp = a.in[6]; f32x4 g[4];
#pragma unroll
        for (int j = 0; j < 4; ++j) g[j] = ((const f32x4*)gp)[lane + 64 * j];
        for (int m = gw; m < MT; m += NGW) {
            const float* xr = m < MP ? a.in[0] + (size_t)m * 1024 : a.in[1] + (size_t)(m - MP) * 1024;
            f32x4 v[4]; float s = 0.f;
#pragma unroll
            for (int j = 0; j < 4; ++j) { v[j] = ((const f32x4*)xr)[lane + 64 * j]; s += (v[j][0] * v[j][0] + v[j][1] * v[j][1]) + (v[j][2] * v[j][2] + v[j][3] * v[j][3]); }
            const float rstd = rsqrtf(wave_sum(s) * (1.0f / 1024.0f) + RMS_EPS);
            u32x2* o = (u32x2*)((bf16_t*)(ws + WS_XN) + (size_t)m * 1024);
#pragma unroll
            for (int j = 0; j < 4; ++j) { u32x2 w; w.x = pk2(v[j][0] * rstd * g[j][0], v[j][1] * rstd * g[j][1]); w.y = pk2(v[j][2] * rstd * g[j][2], v[j][3] * rstd * g[j][3]); o[lane + 64 * j] = w; }
        }
    }
    for (int i = gt; i < DECB * PAST * 512 / 4; i += NGT) {
        const int e = i * 4, bt = e >> 9, c = e & 511, b = bt >> 10, t = bt & 1023; const size_t d = (size_t)(MP + b * TS + t) * 512 + c;
        const f32x4 k = ((const f32x4*)a.in[2])[i], v = ((const f32x4*)a.in[3])[i];
        *(u32x2*)((bf16_t*)(ws + WS_KA) + d) = (u32x2){pk2(k[0], k[1]), pk2(k[2], k[3])};
        *(u32x2*)((bf16_t*)(ws + WS_VA) + d) = (u32x2){pk2(v[0], v[1]), pk2(v[2], v[3])};
    }
    for (int i = gt; i < DECB * PAST * 256 / 4; i += NGT) {
        const int e = i * 4, bt = e >> 8, c = e & 255, b = bt >> 10, t = bt & 1023; const size_t d = (size_t)(MP + b * TS + t) * 256 + c;
        const f32x4 k = ((const f32x4*)a.in[4])[i];
        *(u32x2*)((bf16_t*)(ws + WS_CALL) + d) = (u32x2){pk2(k[0], k[1]), pk2(k[2], k[3])};
    }
    for (int i = gt; i < DECB * PAST * 32 / 4; i += NGT) {
        const int e = i * 4, bt = e >> 5, c = e & 31, b = bt >> 10, t = bt & 1023; const size_t d = (size_t)(MP + b * TS + t) * 32 + c;
        const f32x4 k = ((const f32x4*)a.in[5])[i];
        *(u32x2*)((bf16_t*)(ws + WS_KR) + d) = (u32x2){pk2(k[0], k[1]), pk2(k[2], k[3])};
    }
}

constexpr int A_KBUF = 16384, A_VBUF = 16384, A_BUF = A_KBUF + A_VBUF;
constexpr int A_X = 2 * A_BUF, A_WS = A_X + 65536;
constexpr float A_THR = 8.0f;
#define MFMA32(a, b, c) __builtin_amdgcn_mfma_f32_32x32x16_bf16(a, b, c, 0, 0, 0)
typedef short v4i16_t __attribute__((ext_vector_type(4)));
__device__ __forceinline__ s16x4 vtr(const LAS unsigned char* p) { return __builtin_bit_cast(s16x4, __builtin_amdgcn_ds_read_tr16_b64_v4i16((LAS v4i16_t*)p)); }

struct AUnit { int qrow0, kbase, nt, nrow, h; };

template <bool DA>
__device__ __forceinline__ void attn_unit(LAS unsigned char* lds, const AUnit U, const Args& a) {
    constexpr int DQK = DA ? 64 : 96, DV = DA ? 128 : 64, ND0 = DQK / 16, NDB = DV / 32;
    constexpr int KCH = DA ? 16 : 12;
    constexpr int NKP = KCH * 64 / 512 + ((KCH * 64) % 512 ? 1 : 0), NVP = NDB * 256 / 512 + ((NDB * 256) % 512 ? 1 : 0);
    const int tid = threadIdx.x, lane = tid & 63, r32 = lane & 31, hi = lane >> 5; const int wid = __builtin_amdgcn_readfirstlane(tid >> 6);
    unsigned char* ws = a.ws;
    const int wq = DA ? (wid & 3) : wid, comp = DA ? (wid >> 2) : 0;
    const int wrow = wq * 32; const bool active = wrow < U.nrow;
    const int myrow0 = U.qrow0 + wrow;
    const int my_nt = active ? (tok_pos(myrow0) >> 6) + 1 : 0;
    bf16x8 qr[ND0];
    {
        const bf16_t* Qb = DA ? (const bf16_t*)(ws + WS_QA) + (size_t)(myrow0 + r32) * 512 + U.h * 128 + comp * 64 : (const bf16_t*)(ws + WS_QM) + (size_t)(myrow0 + r32) * 768 + U.h * 96;
#pragma unroll
        for (int d0 = 0; d0 < ND0; ++d0) qr[d0] = active ? *(const bf16x8*)(Qb + d0 * 16 + hi * 8) : (bf16x8){0, 0, 0, 0, 0, 0, 0, 0};
    }
    const bf16_t* kp[NKP]; int kl[NKP]; bool kok[NKP]; const bf16_t* vp[NVP]; int vl[NVP];
#pragma unroll
    for (int i = 0; i < NKP; ++i) { const int p = tid + 512 * i, row = p & 63, ch = p >> 6; kok[i] = ch < KCH; kl[i] = ch * 1024 + row * 16;
        if (DA) kp[i] = (const bf16_t*)(ws + WS_KA) + (size_t)(U.kbase + row) * 512 + U.h * 128 + ch * 8;
        else kp[i] = ch < 8 ? (const bf16_t*)(ws + WS_KN) + (size_t)(U.kbase + row) * 512 + U.h * 64 + ch * 8 : (const bf16_t*)(ws + WS_KR) + (size_t)(U.kbase + row) * 32 + (ch - 8) * 8; }
    const int kstep = DA ? 64 * 512 : 0;
#pragma unroll
    for (int i = 0; i < NVP; ++i) { const int p = tid + 512 * i, sub = p & 3, row = (p >> 2) & 63, db = p >> 8; vl[i] = db * 4096 + row * 64 + sub * 16;
        vp[i] = DA ? (const bf16_t*)(ws + WS_VA) + (size_t)(U.kbase + row) * 512 + U.h * 128 + db * 32 + sub * 8 : (const bf16_t*)(ws + WS_VM) + (size_t)(U.kbase + row) * 512 + U.h * 64 + db * 32 + sub * 8; }
    u32x4 rk[NKP], rv[NVP];
    auto stage_load = [&](int t) {
#pragma unroll
        for (int i = 0; i < NKP; ++i) if (kok[i]) { const int p = tid + 512 * i, ch = p >> 6; const size_t off = DA ? (size_t)t * 64 * 512 : (ch < 8 ? (size_t)t * 64 * 512 : (size_t)t * 64 * 32); rk[i] = *(const u32x4*)(kp[i] + off); }
#pragma unroll
        for (int i = 0; i < NVP; ++i) rv[i] = *(const u32x4*)(vp[i] + (size_t)t * 64 * 512);
    };
    auto stage_write = [&](int buf) {
        LAS unsigned char* kb = lds + buf * A_BUF; LAS unsigned char* vb = kb + A_KBUF;
#pragma unroll
        for (int i = 0; i < NKP; ++i) if (kok[i]) *(LAS u32x4*)(kb + kl[i]) = rk[i];
#pragma unroll
        for (int i = 0; i < NVP; ++i) *(LAS u32x4*)(vb + vl[i]) = rv[i];
    };
    (void)kstep;
    LAS float* wsf = (LAS float*)(lds + A_WS) + wid * 64;
    const int koff = hi * 1024 + r32 * 16 + (DA ? comp * 8192 : 0);
    const int voff = ((lane >> 4) & 1) * 32 + (lane & 3) * 8 + (4 * hi + ((lane & 15) >> 2)) * 64;
    f32x16 o[NDB];
#pragma unroll
    for (int d = 0; d < NDB; ++d) o[d] = f32x16{};
    float mrow = 0.f, lrow = 0.f;
    stage_load(0); stage_write(0); __syncthreads();
    for (int t = 0; t < U.nt; ++t) {
        if (t + 1 < U.nt) stage_load(t + 1);
        if (t < my_nt) {
            const LAS unsigned char* kb = lds + (t & 1) * A_BUF + koff; const LAS unsigned char* vb = lds + (t & 1) * A_BUF + A_KBUF + voff;
            f32x16 p0 = f32x16{}, p1 = f32x16{};
#pragma unroll
            for (int d0 = 0; d0 < ND0; ++d0) { const bf16x8 k0 = *(const LAS bf16x8*)(kb + d0 * 2048), k1 = *(const LAS bf16x8*)(kb + d0 * 2048 + 512); p0 = MFMA32(k0, qr[d0], p0); p1 = MFMA32(k1, qr[d0], p1); }
            float rm = fmaxf(p0[0], p1[0]);
#pragma unroll
            for (int r = 1; r < 16; ++r) rm = fmaxf(rm, fmaxf(p0[r], p1[r]));
            rm = fmaxf(rm, __shfl_xor(rm, 32));
            if (t == 0) mrow = rm;
            else if (__any(rm > mrow + A_THR)) {
                const float mn = fmaxf(mrow, rm), al = exp2f(mrow - mn); mrow = mn; lrow *= al;
                if (hi == 0) wsf[r32] = al;
                asm volatile("s_waitcnt lgkmcnt(0)" ::: "memory");
#pragma unroll
                for (int r = 0; r < 16; ++r) { const float f = wsf[crow(r, hi)];
#pragma unroll
                    for (int d = 0; d < NDB; ++d) o[d][r] *= f; }
                asm volatile("s_waitcnt lgkmcnt(0)" ::: "memory");
            }
            float sacc = 0.f;
#pragma unroll
            for (int r = 0; r < 16; ++r) { p0[r] = __builtin_amdgcn_exp2f(p0[r] - mrow); p1[r] = __builtin_amdgcn_exp2f(p1[r] - mrow); sacc += p0[r] + p1[r]; }
            lrow += sacc;
            bf16x8 pw[4];
            pw[0] = __builtin_bit_cast(bf16x8, (u32x4){pk2(p0[0], p0[1]), pk2(p0[2], p0[3]), pk2(p0[4], p0[5]), pk2(p0[6], p0[7])});
            pw[1] = __builtin_bit_cast(bf16x8, (u32x4){pk2(p0[8], p0[9]), pk2(p0[10], p0[11]), pk2(p0[12], p0[13]), pk2(p0[14], p0[15])});
            pw[2] = __builtin_bit_cast(bf16x8, (u32x4){pk2(p1[0], p1[1]), pk2(p1[2], p1[3]), pk2(p1[4], p1[5]), pk2(p1[6], p1[7])});
            pw[3] = __builtin_bit_cast(bf16x8, (u32x4){pk2(p1[8], p1[9]), pk2(p1[10], p1[11]), pk2(p1[12], p1[13]), pk2(p1[14], p1[15])});
#pragma unroll
            for (int d = 0; d < NDB; ++d)
#pragma unroll
                for (int ks = 0; ks < 4; ++ks) { const s16x4 lo = vtr(vb + d * 4096 + ks * 1024), hh = vtr(vb + d * 4096 + ks * 1024 + 512);
                    const bf16x8 vf = (bf16x8){lo[0], lo[1], lo[2], lo[3], hh[0], hh[1], hh[2], hh[3]};
                    o[d] = MFMA32(pw[ks], vf, o[d]); }
        }
        if (t + 1 < U.nt) stage_write((t + 1) & 1);
        __syncthreads();
    }
    lrow += __shfl_xor(lrow, 32);
    if (hi == 0) wsf[r32] = active ? 1.0f / lrow : 0.f;
    asm volatile("s_waitcnt lgkmcnt(0)" ::: "memory");
    float il[16];
#pragma unroll
    for (int r = 0; r < 16; ++r) il[r] = wsf[crow(r, hi)];
    asm volatile("s_waitcnt lgkmcnt(0)" ::: "memory");
    if (DA) {
        LAS float* X = (LAS float*)(lds + A_X) + (size_t)wq * (NDB * 16 * 64);
        if (comp == 1) {
#pragma unroll
            for (int d = 0; d < NDB; ++d)
#pragma unroll
                for (int r = 0; r < 16; ++r) X[(d * 16 + r) * 64 + lane] = o[d][r] * il[r];
        }
        __syncthreads();
        if (comp == 0 && active) {
            const float lam = ((const float*)(ws + WS_LAM))[0];
            float ss[16];
#pragma unroll
            for (int r = 0; r < 16; ++r) { ss[r] = 0.f;
#pragma unroll
                for (int d = 0; d < NDB; ++d) { const float x = o[d][r] * il[r] - lam * X[(d * 16 + r) * 64 + lane]; o[d][r] = x; ss[r] += x * x; } }
#pragma unroll
            for (int r = 0; r < 16; ++r) { float s = ss[r]; s += __shfl_xor(s, 1); s += __shfl_xor(s, 2); s += __shfl_xor(s, 4); s += __shfl_xor(s, 8); s += __shfl_xor(s, 16); ss[r] = rsqrtf(s * (1.0f / 128.0f) + RMS_EPS) * (1.0f - LAM_INIT); }
            const float* gh = a.in[10];
            const bf16_t* sz = (const bf16_t*)(ws + WS_SZA); bf16_t* ua = (bf16_t*)(ws + WS_UA);
#pragma unroll
            for (int d = 0; d < NDB; ++d) { const int col = U.h * 128 + d * 32 + r32; const float g = gh[d * 32 + r32];
#pragma unroll
                for (int r = 0; r < 16; ++r) { const size_t idx = (size_t)(myrow0 + crow(r, hi)) * 512 + col; ua[idx] = (bf16_t)(pk2(o[d][r] * ss[r] * g * bf2f(sz[idx]), 0.f) & 0xffffu); } }
        }
        __syncthreads();
    } else {
        if (active) {
            const bf16_t* sz = (const bf16_t*)(ws + WS_SZB); bf16_t* ub = (bf16_t*)(ws + WS_UB);
#pragma unroll
            for (int d = 0; d < NDB; ++d) { const int col = U.h * 64 + d * 32 + r32;
#pragma unroll
                for (int r = 0; r < 16; ++r) { const size_t idx = (size_t)(myrow0 + crow(r, hi)) * 512 + col; ub[idx] = (bf16_t)(pk2(o[d][r] * il[r] * bf2f(sz[idx]), 0.f) & 0xffffu); } }
        }
    }
}
constexpr int A_ITEMS_P = 4096, A_ITEMS = A_ITEMS_P + 32 + 64;
__device__ __forceinline__ void attn_phase(LAS unsigned char* lds, const Args& a) {
    unsigned* ctr = (unsigned*)(a.ws + WS_CTL);
    volatile LAS int* misc = (volatile LAS int*)(lds + LDS_MISC);
    for (;;) {
        if (threadIdx.x == 0) misc[0] = (int)atomicAdd(ctr, 1u);
        __syncthreads();
        const int it = misc[0];
        __syncthreads();
        if (it >= A_ITEMS) break;
        AUnit U;
        if (it < A_ITEMS_P) {
            const int r = it >> 7, j = it & 127;
            if (j < 64) { const int b = j >> 2, qb = 31 - r; U.h = j & 3; U.qrow0 = b * SEQ + qb * 128; U.kbase = b * SEQ; U.nt = 2 * qb + 2; U.nrow = 128; attn_unit<true>(lds, U, a); }
            else { const int bh = 2 * (j - 64) + (r & 1), b = bh >> 3, qb = 15 - (r >> 1); U.h = bh & 7; U.qrow0 = b * SEQ + qb * 256; U.kbase = b * SEQ; U.nt = 4 * qb + 4; U.nrow = 256; attn_unit<false>(lds, U, a); }
        } else if (it < A_ITEMS_P + 32) {
            const int j = it - A_ITEMS_P, b = j >> 2; U.h = j & 3; U.qrow0 = MP + b * 64; U.kbase = MP + b * TS; U.nt = 17; U.nrow = 64; attn_unit<true>(lds, U, a);
        } else {
            const int j = it - A_ITEMS_P - 32, b = j >> 3; U.h = j & 7; U.qrow0 = MP + b * 64; U.kbase = MP + b * TS; U.nt = 17; U.nrow = 64; attn_unit<false>(lds, U, a);
        }
    }
}

__global__ void __launch_bounds__(NTHREADS, 2) mega_fwd(Args a) {
    extern __shared__ __attribute__((aligned(16))) unsigned char lds_raw[];
    LAS unsigned char* lds = (LAS unsigned char*)lds_raw;
    cg::grid_group grid = cg::this_grid();
    unsigned char* ws = a.ws; float* out = a.out;
    const int G = gridDim.x, bid = blockIdx.x, tid = threadIdx.x, lane = tid & 63, wave = tid >> 6;
    const int lo = a.ph_lo, hi = a.ph_hi;
#define IN(k) (lo <= (k) && (k) < hi)
#define SEAM(k) do { if (IN(k) && IN((k) + 1)) grid.sync(); } while (0)
    const f32x2* cs_da = (const f32x2*)(ws + WS_ROPE_DA); const f32x2* cs_ml = (const f32x2*)(ws + WS_ROPE_ML);
    if (IN(0)) p0_prologue(a, lds);
    SEAM(0);
    if (IN(1)) {
        Epi1 E{(bf16_t*)(ws + WS_QA), (bf16_t*)(ws + WS_KA), (bf16_t*)(ws + WS_VA), (bf16_t*)(ws + WS_SZA), (bf16_t*)(ws + WS_SZB), (bf16_t*)(out + O_Y), (bf16_t*)(ws + WS_CQ), (bf16_t*)(ws + WS_CALL), (bf16_t*)(ws + WS_KR),
               (float*)(ws + WS_SSQ), (float*)(ws + WS_SSKV), out, a.in[8], a.in[11], a.in[12], cs_da, cs_ml};
        constexpr int nN = NIN / 256, nU = (MT / 256) * nN;
        for (int i = bid; i < nU; i += G) { Unit u{i / nN, i % nN, 0}; gemm_tile(lds, (const bf16_t*)(ws + WS_XN), (const bf16_t*)(ws + WS_WIN), 1024, u, E); }
    }
    SEAM(1);
    if (IN(2)) {
        Epi2a Ea{(bf16_t*)(ws + WS_QM), (const float*)(ws + WS_SSQ), cs_ml};
        Epi2b Eb{(bf16_t*)(ws + WS_KN), (bf16_t*)(ws + WS_VM), (const float*)(ws + WS_SSKV)};
        constexpr int nUa = (MT / 256) * 3, nUb = (KR / 256) * 4;
        for (int i = bid; i < nUa + nUb; i += G) {
            if (i < nUa) { Unit u{i / 3, i % 3, 0}; gemm_tile(lds, (const bf16_t*)(ws + WS_CQ), (const bf16_t*)(ws + WS_WUQ), 384, u, Ea); }
            else { const int k = i - nUa; Unit u{k / 4, k % 4, 0}; gemm_tile(lds, (const bf16_t*)(ws + WS_CALL), (const bf16_t*)(ws + WS_WUKV), 256, u, Eb); }
        }
        for (int m = bid * NWAVES + wave; m < MT; m += G * NWAVES) {
            const float* p = (const float*)(ws + WS_SSKV) + (size_t)m * 8; float s = 0.f;
#pragma unroll
            for (int j = 0; j < 8; ++j) s += p[j];
            const float rstd = rsqrtf(s * (1.0f / 256.0f) + RMS_EPS);
            f32x4* r = (f32x4*)(m < MP ? out + O_LP + (size_t)m * 256 : out + O_LS + (size_t)(m - MP) * 256) + lane;
            f32x4 v = *r; v = v * rstd; *r = v;
        }
    }
    SEAM(2);
    if (IN(3)) attn_phase(lds, a);
    SEAM(3);
    if (IN(4)) {
        Epi3a Ea{(float*)(ws + WS_T), (const bf16_t*)(out + O_Y)};
        Epi3b Eb{(const float*)(ws + WS_T), (const bf16_t*)(out + O_Y), (bf16_t*)(ws + WS_MM)};
        constexpr int nU = (MT / 256) * 4;
        for (int i = bid; i < nU; i += G) { Unit u{i / 4, i % 4, 0};
            gemm_tile(lds, (const bf16_t*)(ws + WS_UA), (const bf16_t*)(ws + WS_WA), 512, u, Ea);
            asm volatile("s_waitcnt vmcnt(0)" ::: "memory");
            gemm_tile(lds, (const bf16_t*)(ws + WS_UB), (const bf16_t*)(ws + WS_WB), 512, u, Eb); }
    }
    SEAM(4);
    if (IN(5)) {
        Epi4 E{a.in[0], a.in[1], out + O_Y, (float*)(ws + WS_SSY)};
        constexpr int nU = (MT / 256) * 4;
        for (int i = bid; i < nU; i += G) { Unit u{i / 4, i % 4, 0}; gemm_tile(lds, (const bf16_t*)(ws + WS_MM), (const bf16_t*)(ws + WS_WOUT), 1024, u, E); }
    }
    SEAM(5);
    if (IN(6)) {
        f32x4 g[4];
#pragma unroll
        for (int j = 0; j < 4; ++j) g[j] = ((const f32x4*)a.in[19])[lane + 64 * j];
        for (int m = bid * NWAVES + wave; m < MT; m += G * NWAVES) {
            const float* p = (const float*)(ws + WS_SSY) + (size_t)m * 32;
            const float s = wave_sum(lane < 32 ? p[lane] : 0.f);
            const float rstd = rsqrtf(s * (1.0f / 1024.0f) + RMS_EPS);
            f32x4* r = (f32x4*)(out + O_Y + (size_t)m * 1024);
#pragma unroll
            for (int j = 0; j < 4; ++j) { f32x4 v = r[lane + 64 * j]; v = v * rstd * g[j]; r[lane + 64 * j] = v; }
        }
    }
#undef IN
#undef SEAM
}

extern "C" void kernel_launch(void* const* d_in, const int* in_sizes, int n_in, void* d_out, int out_size, void* d_ws, size_t ws_size, hipStream_t stream) {
    static int grid = 0;
    if (grid == 0) {
        if (n_in != 20 || (size_t)out_size != O_END || ws_size < WS_END) { fprintf(stderr, "kernel_launch: unexpected shapes (n_in %d out %d ws %zu)\n", n_in, out_size, ws_size); grid = -1; return; }
        int dev = 0, cus = 0, per_cu = 0;
        hipGetDevice(&dev); hipDeviceGetAttribute(&cus, hipDeviceAttributeMultiprocessorCount, dev);
        if (hipFuncSetAttribute((const void*)mega_fwd, hipFuncAttributeMaxDynamicSharedMemorySize, LDS_BYTES) != hipSuccess) { fprintf(stderr, "kernel_launch: hipFuncSetAttribute failed\n"); grid = -1; return; }
        if (hipOccupancyMaxActiveBlocksPerMultiprocessor(&per_cu, (const void*)mega_fwd, NTHREADS, LDS_BYTES) != hipSuccess || per_cu < 1) { fprintf(stderr, "kernel_launch: occupancy query says %d\n", per_cu); (void)hipGetLastError(); grid = -1; return; }
        grid = cus;
        if (grid > cus * per_cu) grid = cus * per_cu;
    }
    if (grid < 0) return;
    Args a{};
    for (int i = 0; i < 20; ++i) a.in[i] = (const float*)d_in[i];
    a.out = (float*)d_out; a.ws = (unsigned char*)d_ws;
#if MK_N_LAUNCHES == 1
    a.ph_lo = 0; a.ph_hi = 7;
    void* args[] = {&a};
    hipError_t e = hipLaunchCooperativeKernel((const void*)mega_fwd, dim3(grid), dim3(NTHREADS), args, LDS_BYTES, stream);
    if (e != hipSuccess) fprintf(stderr, "cooperative launch failed: %s (grid %d)\n", hipGetErrorString(e), grid);
#else
    for (int p = 0; p < 7; ++p) { a.ph_lo = p; a.ph_hi = p + 1; hipLaunchKernelGGL(mega_fwd, dim3(grid), dim3(NTHREADS), LDS_BYTES, stream, a); }
#endif
}
```

```cpp
#include <hip/hip_runtime.h>
#include <hip/hip_cooperative_groups.h>
#include <cstdio>
#include <cstdint>
namespace cg = cooperative_groups;

#ifndef MK_N_LAUNCHES
#define MK_N_LAUNCHES 1
#endif

#ifndef PROBE_REP
#define PROBE_REP -1
#endif
#define LAS __attribute__((address_space(3)))
typedef unsigned short bf16_t;
typedef short bf16x8 __attribute__((ext_vector_type(8)));
typedef short s16x4 __attribute__((ext_vector_type(4)));
typedef float f32x2 __attribute__((ext_vector_type(2)));
typedef float f32x4 __attribute__((ext_vector_type(4)));
typedef float f32x16 __attribute__((ext_vector_type(16)));
typedef unsigned u32x2 __attribute__((ext_vector_type(2)));
typedef unsigned u32x4 __attribute__((ext_vector_type(4)));
typedef __bf16 bf16x2_t __attribute__((ext_vector_type(2)));

constexpr int DM = 1024, NB = 16, SEQ = 4096, DECB = 8, DECS = 64, PAST = 1024;
constexpr int MP = NB * SEQ;
constexpr int MS = DECB * DECS;
constexpr int MT = MP + MS;
constexpr int TS = PAST + DECS;
constexpr int KR = MP + DECB * TS;
constexpr int NIN = 5376;
constexpr float RMS_EPS = 1e-6f;
constexpr float LOG2E = 1.4426950408889634f;
constexpr float C2A = 0.125f * LOG2E;
constexpr float C2M = 0.10206207261596575f * LOG2E;
constexpr float LAM_INIT = 0.2f;
constexpr size_t O_Y = 0;
constexpr size_t O_KP = (size_t)MT * 1024;
constexpr size_t O_VP = O_KP + (size_t)MP * 512;
constexpr size_t O_LP = O_VP + (size_t)MP * 512;
constexpr size_t O_RP = O_LP + (size_t)MP * 256;
constexpr size_t O_KS = O_RP + (size_t)MP * 32;
constexpr size_t O_VS = O_KS + (size_t)MS * 512;
constexpr size_t O_LS = O_VS + (size_t)MS * 512;
constexpr size_t O_RS = O_LS + (size_t)MS * 256;
constexpr size_t O_END = O_RS + (size_t)MS * 32;
constexpr size_t MiB = 1u << 20;
constexpr size_t WS_CTL = 0, WS_LAM = 4096, WS_ROPE_DA = 8192, WS_ROPE_ML = WS_ROPE_DA + 4096 * 8 * 8;
constexpr size_t WS_WIN = 1 * MiB, WS_WUQ = 12 * MiB, WS_WUKV = 13 * MiB, WS_WA = 14 * MiB, WS_WB = 15 * MiB, WS_WOUT = 16 * MiB;
constexpr size_t WS_SSQ = 18 * MiB, WS_SSKV = 23 * MiB, WS_SSY = 26 * MiB;
constexpr size_t WS_XN = 36 * MiB;
constexpr size_t WS_UA = WS_XN, WS_UB = WS_XN + (size_t)MT * 512 * 2;
constexpr size_t WS_QA = 166 * MiB, WS_KA = 231 * MiB, WS_VA = 304 * MiB, WS_SZA = 377 * MiB;
constexpr size_t WS_T = WS_QA;
constexpr size_t WS_SZB = 442 * MiB, WS_CQ = 507 * MiB, WS_CALL = 556 * MiB, WS_KR = 611 * MiB;
constexpr size_t WS_QM = 616 * MiB, WS_KN = 713 * MiB, WS_VM = 786 * MiB;
constexpr size_t WS_MM = WS_QM;
constexpr size_t WS_END = 859 * MiB;
static_assert(WS_XN + (size_t)MT * 1024 * 2 <= WS_QA && WS_T + (size_t)MT * 1024 * 4 <= WS_SZB && WS_MM + (size_t)MT * 1024 * 2 <= WS_VM + (size_t)KR * 512 * 2, "ws map");
static_assert(WS_QA + (size_t)MT * 512 * 2 <= WS_KA && WS_KA + (size_t)KR * 512 * 2 <= WS_VA && WS_VA + (size_t)KR * 512 * 2 <= WS_SZA && WS_SZA + (size_t)MT * 512 * 2 <= WS_SZB, "ws map 2");
static_assert(WS_SZB + (size_t)MT * 512 * 2 <= WS_CQ && WS_CQ + (size_t)MT * 384 * 2 <= WS_CALL && WS_CALL + (size_t)KR * 384 * 2 <= WS_KR && WS_KR + (size_t)KR * 32 * 2 <= WS_QM, "ws map 3");
static_assert(WS_QM + (size_t)MT * 768 * 2 <= WS_KN && WS_KN + (size_t)KR * 512 * 2 <= WS_VM && WS_VM + (size_t)KR * 512 * 2 <= WS_END, "ws map 4");
static_assert(WS_WIN + (size_t)NIN * 1024 * 2 <= WS_WUQ && WS_SSQ + (size_t)MT * 16 * 4 <= WS_SSKV && WS_SSKV + (size_t)MT * 8 * 4 <= WS_SSY && WS_SSY + (size_t)MT * 32 * 4 <= WS_XN, "ws map 5");

constexpr int NTHREADS = 512, NWAVES = 8;
constexpr int LDS_BYTES = 139264;
constexpr int LDS_MISC = 135168;

__constant__ float c_inv_da[8] = {1.0f, 0.1939227432012558f, 0.03760603070259094f, 0.007292664609849453f, 0.0014142135623842478f, 0.00027424818836152554f, 5.318296098266728e-05f, 1.0313386155758053e-05f};
__constant__ float c_inv_ml[16] = {1.0f, 0.44036659598350525f, 0.1939227432012558f, 0.08539710193872452f, 0.03760603070259094f, 0.01656043902039528f, 0.007292664609849453f, 0.0032114458736032248f,
                                   0.0014142135623842478f, 0.000622772378847003f, 0.00027424818836152554f, 0.00012076973507646471f, 5.318296098266728e-05f, 2.34199997066753e-05f, 1.0313386155758053e-05f, 4.541670477919979e-06f};

__device__ __forceinline__ unsigned pk2(float lo, float hi) { f32x2 v = {lo, hi}; bf16x2_t b = __builtin_convertvector(v, bf16x2_t); return __builtin_bit_cast(unsigned, b); }
__device__ __forceinline__ float bflo(unsigned u) { return __builtin_bit_cast(float, u << 16); }
__device__ __forceinline__ float bfhi(unsigned u) { return __builtin_bit_cast(float, u & 0xffff0000u); }
__device__ __forceinline__ float bf2f(bf16_t h) { return __builtin_bit_cast(float, (unsigned)h << 16); }
__device__ __forceinline__ u32x4 pack8(const float* v) { u32x4 w; w.x = pk2(v[0], v[1]); w.y = pk2(v[2], v[3]); w.z = pk2(v[4], v[5]); w.w = pk2(v[6], v[7]); return w; }
__device__ __forceinline__ void unpack8(u32x4 w, float* v) { v[0] = bflo(w.x); v[1] = bfhi(w.x); v[2] = bflo(w.y); v[3] = bfhi(w.y); v[4] = bflo(w.z); v[5] = bfhi(w.z); v[6] = bflo(w.w); v[7] = bfhi(w.w); }
__device__ __forceinline__ int tok_pos(int row) { return row < MP ? (row & (SEQ - 1)) : PAST + ((row - MP) & (DECS - 1)); }
__device__ __forceinline__ int tok_krow(int row) { return row < MP ? row : MP + ((row - MP) >> 6) * TS + PAST + ((row - MP) & 63); }
__device__ __forceinline__ float wave_sum(float v) {
#pragma unroll
    for (int o = 1; o < 64; o <<= 1) v += __shfl_xor(v, o);
    return v;
}
__device__ __forceinline__ float sigmoidf_(float x) { return 1.0f / (1.0f + __expf(-x)); }
__device__ __forceinline__ float siluf_(float x) { return x / (1.0f + __expf(-x)); }
__device__ __forceinline__ int crow(int r, int hi) { return (r & 3) + 8 * (r >> 2) + 4 * hi; }
__host__ __device__ __forceinline__ int perm32(int rho) { const int n = rho >> 4, i = rho & 15; return 8 * (i >> 2) + 4 * n + (i & 3); }

struct Args {
    const float* in[20]; float* out; unsigned char* ws; int ph_lo, ph_hi;
};

namespace pg8 {
#define PG8_LAS __attribute__((address_space(3)))
constexpr int BM = 256, BK = 64, HALF = 128, HTB = HALF * BK * 2  , STAGE_BYTES = 8 * HTB, NXCD = 8, WGM = 8;
__host__ __device__ __forceinline__ int lds_byte(int r, int c) { const int st = (r >> 4) * 2 + (c >> 5), rr = r & 15, cc = c & 31, ob = rr * 64 + cc * 2; return st * 1024 + (ob ^ (((ob >> 9) & 1) << 5)); }
__host__ __device__ __forceinline__ void stage_rc(int b, int& R, int& C) { const int st = b / 1024, sb = b % 1024, swz = sb ^ (((sb >> 9) & 1) << 5); R = (st >> 1) * 16 + swz / 64; C = (st & 1) * 32 + (swz % 64) / 2; }
struct Unit { int pm, pn, src, nt; };
struct Gemm { const bf16_t *A0, *A1, *B0, *B1; int K; };
struct StaticOrder {
    int nM, nN, nwg, G, c;
    __host__ __device__ void init(int M, int N, int G_, int c_) { nM = M / BM; nN = N / BM; nwg = nM * nN; G = G_; c = c_; }
    __host__ __device__ bool next(int i, Unit& u) const {
        const long L = (long)i * G + c; if (L >= nwg) return false;
        int wgid = (int)L; { const int q = nwg / NXCD, r = nwg % NXCD, xcd = wgid % NXCD, off = wgid / NXCD; wgid = (xcd < r ? xcd * (q + 1) : r * (q + 1) + (xcd - r) * q) + off; }
        const int nig = WGM * nN, gid = wgid / nig, fm = gid * WGM, gsz = (nM - fm) < WGM ? (nM - fm) : WGM;
        u.pm = fm + ((wgid % nig) % gsz); u.pn = (wgid % nig) / gsz; return true;
    }
};
template <class Epi, class Sched, bool ALIGN_EPI = false, bool SP2 = false>
__device__ __forceinline__ void gemm_phase(PG8_LAS unsigned char* lds, const Gemm g, const Sched& S, const Epi& E) {
    const int tid = threadIdx.x, wid = __builtin_amdgcn_readfirstlane(tid >> 6), lane = tid & 63, wr = wid >> 2, wc = wid & 3, fr = lane & 15, fq = lane >> 4;
    const int K = g.K;
    unsigned voffA[2], voffB[2];
#pragma unroll
    for (int i = 0; i < 2; ++i) { int R, C; stage_rc(tid * 16 + i * 8192, R, C); const int Rb = Epi::PERM ? ((R & ~31) + perm32(R & 31)) : R;
        voffA[i] = (unsigned)(R * K + C) * 2u; voffB[i] = (unsigned)(Rb * K + C) * 2u; }
    const size_t kstep = (size_t)(BK * 2);
    const size_t hstep = (size_t)HALF * K * 2;
    const size_t tstep = 2 * hstep;
    const unsigned ldsw = (unsigned)wid * 1024u;
    const int aoff = lds_byte(wr * 64 + fr, fq * 8), boff = lds_byte(wc * 32 + fr, fq * 8);
#define PG8_SA(b, h) (((b) * 2 + (h)) * HTB)
#define PG8_SB(b, h) ((4 + (b) * 2 + (h)) * HTB)
#define PG8_STAGE(bufoff, gbase, voff) do { _Pragma("unroll") for (int _i = 0; _i < 2; ++_i) \
        __builtin_amdgcn_global_load_lds((const unsigned*)((const char*)(gbase) + (voff)[_i]), (PG8_LAS unsigned*)(lds + (bufoff) + ldsw + _i * 8192), 16, 0, 0); } while (0)
#define PG8_LDA(dst, b, h) do { _Pragma("unroll") for (int m = 0; m < 4; ++m) _Pragma("unroll") for (int k = 0; k < 2; ++k) dst[m][k] = *(const PG8_LAS bf16x8*)(lds + PG8_SA(b, h) + aoff + m * 2048 + k * 1024); } while (0)
#define PG8_LDB(dst, b, h) do { _Pragma("unroll") for (int n = 0; n < 2; ++n) _Pragma("unroll") for (int k = 0; k < 2; ++k) dst[n][k] = *(const PG8_LAS bf16x8*)(lds + PG8_SB(b, h) + boff + n * 2048 + k * 1024); } while (0)
#define PG8_MMA(ai, bj, At, Bt) do { __builtin_amdgcn_s_setprio(1); _Pragma("unroll") for (int m = 0; m < 4; ++m) _Pragma("unroll") for (int n = 0; n < 2; ++n) _Pragma("unroll") for (int k = 0; k < 2; ++k) \
        acc[ai][bj][m][n] = __builtin_amdgcn_mfma_f32_16x16x32_bf16(Bt[n][k], At[m][k], acc[ai][bj][m][n], 0, 0, 0); __builtin_amdgcn_s_setprio(0); } while (0)
#define PG8_WAIT_V(n) asm volatile("s_waitcnt vmcnt(" #n ")" ::: "memory")
#define PG8_WAIT_L(n) asm volatile("s_waitcnt lgkmcnt(" #n ")" ::: "memory")
#define PG8_BAR __builtin_amdgcn_s_barrier()
#define PG8_SCHED __builtin_amdgcn_sched_barrier(0)
    Unit cur, nxt; int ui = 0;
    if (!S.next(0, cur)) return;
    f32x4 acc[2][2][4][2];
#pragma unroll
    for (int a = 0; a < 2; ++a)
#pragma unroll
        for (int b = 0; b < 2; ++b)
#pragma unroll
            for (int m = 0; m < 4; ++m)
#pragma unroll
                for (int n = 0; n < 2; ++n) acc[a][b][m][n] = (f32x4){0.f, 0.f, 0.f, 0.f};
    bf16x8 At[4][2], B0[2][2], B1[2][2];
    const char* cA = (const char*)(cur.src ? g.A1 : g.A0) + (size_t)cur.pm * tstep; const char* cB = (const char*)(cur.src ? g.B1 : g.B0) + (size_t)cur.pn * tstep;
    S.a_ready(cur);
    if constexpr (SP2) {
        PG8_STAGE(PG8_SB(0, 0), cB, voffB); PG8_STAGE(PG8_SB(0, 1), cB + hstep, voffB); PG8_STAGE(PG8_SA(0, 0), cA, voffA); PG8_STAGE(PG8_SA(0, 1), cA + hstep, voffA);
        if (wr == 1) PG8_BAR;
        PG8_WAIT_V(2); PG8_BAR;
        PG8_STAGE(PG8_SB(1, 0), cB + kstep, voffB); PG8_STAGE(PG8_SA(1, 0), cA + kstep, voffA); PG8_STAGE(PG8_SB(1, 1), cB + hstep + kstep, voffB);
        PG8_WAIT_V(6); PG8_BAR;
    } else {
        PG8_STAGE(PG8_SB(0, 0), cB, voffB); PG8_STAGE(PG8_SA(0, 0), cA, voffA); PG8_STAGE(PG8_SB(0, 1), cB + hstep, voffB); PG8_STAGE(PG8_SA(0, 1), cA + hstep, voffA);
        if (wr == 1) PG8_BAR;
        PG8_WAIT_V(4); PG8_BAR;
        PG8_STAGE(PG8_SB(1, 0), cB + kstep, voffB); PG8_STAGE(PG8_SA(1, 0), cA + kstep, voffA); PG8_STAGE(PG8_SB(1, 1), cB + hstep + kstep, voffB);
        PG8_WAIT_V(6); PG8_BAR;
    }
    for (;;) {
        const bool has_next = S.next(ui + 1, nxt);
        const char* nA = has_next ? (const char*)(nxt.src ? g.A1 : g.A0) + (size_t)nxt.pm * tstep : cA; const char* nB = has_next ? (const char*)(nxt.src ? g.B1 : g.B0) + (size_t)nxt.pn * tstep : cB;
        const int nt = cur.nt;
        for (int t = 0; t < nt; t += 2) {
            const bool last = (t == nt - 2);
            const char* a1 = cA + (size_t)(t + 1) * kstep;
            const char* a2 = last ? nA : cA + (size_t)(t + 2) * kstep; const char* b2 = last ? nB : cB + (size_t)(t + 2) * kstep;
            const char* a3 = a2 + kstep; const char* b3 = b2 + kstep;
            if (last && has_next) S.a_ready(nxt);
            if constexpr (SP2) {
            PG8_LDB(B0, 0, 0); PG8_LDB(B1, 0, 1); PG8_SCHED; PG8_LDA(At, 0, 0); PG8_STAGE(PG8_SA(1, 1), a1 + hstep, voffA);
            PG8_WAIT_V(8); PG8_WAIT_L(0); PG8_BAR; PG8_MMA(0, 0, At, B0); PG8_MMA(0, 1, At, B1); PG8_BAR; PG8_SCHED;
            PG8_LDA(At, 0, 1); PG8_STAGE(PG8_SB(0, 0), b2, voffB); PG8_STAGE(PG8_SB(0, 1), b2 + hstep, voffB); PG8_STAGE(PG8_SA(0, 0), a2, voffA);
            PG8_WAIT_V(8); PG8_WAIT_L(0); PG8_BAR; PG8_MMA(1, 0, At, B0); PG8_MMA(1, 1, At, B1); PG8_BAR; PG8_SCHED;
            PG8_LDB(B0, 1, 0); PG8_LDB(B1, 1, 1); PG8_SCHED; PG8_LDA(At, 1, 0); PG8_STAGE(PG8_SA(0, 1), a2 + hstep, voffA);
            PG8_WAIT_V(8); PG8_WAIT_L(0); PG8_BAR; PG8_MMA(0, 0, At, B0); PG8_MMA(0, 1, At, B1); PG8_BAR; PG8_SCHED;
            PG8_LDA(At, 1, 1); PG8_STAGE(PG8_SB(1, 0), b3, voffB); PG8_STAGE(PG8_SB(1, 1), b3 + hstep, voffB); PG8_STAGE(PG8_SA(1, 0), a3, voffA);
            PG8_WAIT_V(8); PG8_WAIT_L(0); PG8_BAR; PG8_MMA(1, 0, At, B0); PG8_MMA(1, 1, At, B1); PG8_BAR; PG8_SCHED;
            } else {
            PG8_LDB(B0, 0, 0); PG8_SCHED; PG8_LDA(At, 0, 0); PG8_STAGE(PG8_SA(1, 1), a1 + hstep, voffA);
            PG8_WAIT_L(8); PG8_BAR; PG8_WAIT_L(0); PG8_MMA(0, 0, At, B0); PG8_BAR; PG8_SCHED;
            PG8_LDB(B1, 0, 1); PG8_STAGE(PG8_SB(0, 0), b2, voffB);
            PG8_BAR; PG8_WAIT_L(0); PG8_MMA(0, 1, At, B1); PG8_BAR;
            PG8_LDA(At, 0, 1); PG8_STAGE(PG8_SA(0, 0), a2, voffA);
            PG8_BAR; PG8_WAIT_L(0); PG8_MMA(1, 0, At, B0); PG8_BAR; PG8_SCHED;
            PG8_STAGE(PG8_SB(0, 1), b2 + hstep, voffB);
            PG8_WAIT_V(6); PG8_BAR; PG8_MMA(1, 1, At, B1); PG8_BAR;
            PG8_LDB(B0, 1, 0); PG8_SCHED; PG8_LDA(At, 1, 0); PG8_STAGE(PG8_SA(0, 1), a2 + hstep, voffA);
            PG8_WAIT_L(8); PG8_BAR; PG8_WAIT_L(0); PG8_MMA(0, 0, At, B0); PG8_BAR; PG8_SCHED;
            PG8_LDB(B1, 1, 1); PG8_STAGE(PG8_SB(1, 0), b3, voffB);
            PG8_BAR; PG8_WAIT_L(0); PG8_MMA(0, 1, At, B1); PG8_BAR;
            PG8_LDA(At, 1, 1); PG8_STAGE(PG8_SA(1, 0), a3, voffA);
            PG8_BAR; PG8_WAIT_L(0); PG8_MMA(1, 0, At, B0); PG8_BAR; PG8_SCHED;
            PG8_STAGE(PG8_SB(1, 1), b3 + hstep, voffB);
            PG8_WAIT_V(6); PG8_BAR; PG8_MMA(1, 1, At, B1); PG8_BAR;
            }
        }
        if constexpr (ALIGN_EPI) { if (wr == 0) PG8_BAR; }
        if constexpr (!Epi::AFTER_DRAIN) { int fr_ = fr, fq_ = fq; asm volatile("" : "+v"(fr_), "+v"(fq_));
            E(acc, cur, wr, wc, fr_, fq_); S.done(cur); }
        if (!has_next) break;
#pragma unroll
        for (int a = 0; a < 2; ++a)
#pragma unroll
            for (int b = 0; b < 2; ++b)
#pragma unroll
                for (int m = 0; m < 4; ++m)
#pragma unroll
                    for (int n = 0; n < 2; ++n) acc[a][b][m][n] = (f32x4){0.f, 0.f, 0.f, 0.f};
        cur = nxt; cA = nA; cB = nB; ++ui;
        if constexpr (ALIGN_EPI) { if (wr == 1) PG8_BAR; }
    }
    PG8_WAIT_V(0);
    if constexpr (!ALIGN_EPI) { if (wr == 0) PG8_BAR; }
    PG8_BAR;
    if constexpr (Epi::AFTER_DRAIN) { E.fused(acc, cur, wr, wc, fr, fq, lds, wid, lane); S.done(cur); }
#undef PG8_SA
#undef PG8_SB
#undef PG8_STAGE
#undef PG8_LDA
#undef PG8_LDB
#undef PG8_MMA
#undef PG8_WAIT_V
#undef PG8_WAIT_L
#undef PG8_BAR
#undef PG8_SCHED
}
}
using pg8::Unit;

#define EPI_ROWS_BEGIN \
    _Pragma("unroll") for (int ai = 0; ai < 2; ++ai) _Pragma("unroll") for (int m = 0; m < 4; ++m) { const int row = u.pm * 256 + ai * 128 + wr * 64 + m * 16 + fr;
#define EPI_COLS_BEGIN \
    _Pragma("unroll") for (int bj = 0; bj < 2; ++bj) { const int c8 = u.pn * 256 + bj * 128 + wc * 32 + fq * 8; float v[8]; \
        v[0] = acc[ai][bj][m][0][0]; v[1] = acc[ai][bj][m][0][1]; v[2] = acc[ai][bj][m][0][2]; v[3] = acc[ai][bj][m][0][3]; \
        v[4] = acc[ai][bj][m][1][0]; v[5] = acc[ai][bj][m][1][1]; v[6] = acc[ai][bj][m][1][2]; v[7] = acc[ai][bj][m][1][3];
#define EPI_END } }

__device__ __forceinline__ void st8f(float* p, const float* v) { *(f32x4*)p = (f32x4){v[0], v[1], v[2], v[3]}; *(f32x4*)(p + 4) = (f32x4){v[4], v[5], v[6], v[7]}; }
__device__ __forceinline__ void ld8f(const float* p, float* v) { const f32x4 a = *(const f32x4*)p, b = *(const f32x4*)(p + 4); v[0] = a[0]; v[1] = a[1]; v[2] = a[2]; v[3] = a[3]; v[4] = b[0]; v[5] = b[1]; v[6] = b[2]; v[7] = b[3]; }
template <int XM> __device__ __forceinline__ void rope8(float* v, bool active, bool first, const f32x2* cs) {
    float pr[8];
#pragma unroll
    for (int j = 0; j < 8; ++j) pr[j] = __shfl_xor(v[j], XM);
    if (active) {
#pragma unroll
        for (int j = 0; j < 8; ++j) { const f32x2 c = cs[j]; v[j] = first ? v[j] * c.x - pr[j] * c.y : v[j] * c.x + pr[j] * c.y; }
    }
}

struct Epi1 {
    static constexpr bool PERM = true, AFTER_DRAIN = false;
    unsigned char* ws; float* out; const float *gate_b, *gq, *gkv;
    __device__ __forceinline__ void operator()(const f32x4 (&acc)[2][2][4][2], const Unit& u, int wr, int wc, int fr, int fq) const {
        const int pn = u.pn;
        bf16_t* const QA = (bf16_t*)(ws + WS_QA); bf16_t* const KA = (bf16_t*)(ws + WS_KA); bf16_t* const VA = (bf16_t*)(ws + WS_VA); bf16_t* const SZA = (bf16_t*)(ws + WS_SZA); bf16_t* const SZB = (bf16_t*)(ws + WS_SZB);
        bf16_t* const G = (bf16_t*)(out + O_Y); bf16_t* const CQ = (bf16_t*)(ws + WS_CQ); bf16_t* const CALL = (bf16_t*)(ws + WS_CALL); bf16_t* const KRB = (bf16_t*)(ws + WS_KR);
        float* const SSQ = (float*)(ws + WS_SSQ); float* const SSKV = (float*)(ws + WS_SSKV); const f32x2* const cs_da = (const f32x2*)(ws + WS_ROPE_DA); const f32x2* const cs_ml = (const f32x2*)(ws + WS_ROPE_ML);
        if (pn < 2) {
            EPI_ROWS_BEGIN const int pos = tok_pos(row);
            EPI_COLS_BEGIN
                if ((wc & 1) == 0) rope8<16>(v, fq < 2, fq == 0, cs_da + pos * 8);
#pragma unroll
                for (int j = 0; j < 8; ++j) v[j] *= C2A;
                *(u32x4*)(QA + (size_t)row * 512 + c8) = pack8(v);
            EPI_END
        } else if (pn < 4) {
            EPI_ROWS_BEGIN const int pos = tok_pos(row); const int kr = tok_krow(row);
                float* orow = row < MP ? out + O_KP + (size_t)row * 512 : out + O_KS + (size_t)(row - MP) * 512;
            EPI_COLS_BEGIN const int c = c8 - 512;
                if ((wc & 1) == 0) rope8<16>(v, fq < 2, fq == 0, cs_da + pos * 8);
                st8f(orow + c, v);
                *(u32x4*)(KA + (size_t)kr * 512 + c) = pack8(v);
            EPI_END
        } else if (pn < 6) {
            EPI_ROWS_BEGIN const int kr = tok_krow(row);
                float* orow = row < MP ? out + O_VP + (size_t)row * 512 : out + O_VS + (size_t)(row - MP) * 512;
            EPI_COLS_BEGIN const int c = c8 - 1024;
                st8f(orow + c, v);
                *(u32x4*)(VA + (size_t)kr * 512 + c) = pack8(v);
            EPI_END
        } else if (pn < 10) {
            bf16_t* dst = pn < 8 ? SZA : SZB; const int cb = pn < 8 ? 1536 : 2048;
            EPI_ROWS_BEGIN
            EPI_COLS_BEGIN const int c = c8 - cb;
#pragma unroll
                for (int j = 0; j < 8; ++j) v[j] = siluf_(v[j]);
                *(u32x4*)(dst + (size_t)row * 512 + c) = pack8(v);
            EPI_END
        } else if (pn < 18) {
            EPI_ROWS_BEGIN
            EPI_COLS_BEGIN const int c = c8 - 2560; float b[8]; ld8f(gate_b + c, b);
#pragma unroll
                for (int j = 0; j < 8; ++j) v[j] = sigmoidf_(v[j] + b[j]);
                *(u32x4*)(G + (size_t)row * 2048 + c) = pack8(v);
            EPI_END
        } else if (pn == 20) {
            EPI_ROWS_BEGIN const int kr = tok_krow(row);
                float* orow = row < MP ? out + O_LP + (size_t)row * 256 : out + O_LS + (size_t)(row - MP) * 256;
            EPI_COLS_BEGIN const int c = c8 - 5120; float g[8]; ld8f(gkv + c, g); float ss = 0.f;
#pragma unroll
                for (int j = 0; j < 8; ++j) { ss += v[j] * v[j]; v[j] *= g[j]; }
                ss += __shfl_xor(ss, 16); ss += __shfl_xor(ss, 32);
                if (fq == 0) SSKV[(size_t)row * 8 + bj * 4 + wc] = ss;
                st8f(orow + c, v);
                *(u32x4*)(CALL + (size_t)kr * 384 + c) = pack8(v);
            EPI_END
        } else {
            EPI_ROWS_BEGIN const int pos = tok_pos(row); const int kr = tok_krow(row);
            EPI_COLS_BEGIN
                if (pn == 18 || bj == 0) {
                    const int c = c8 - 4608; float g[8]; ld8f(gq + c, g); float ss = 0.f;
#pragma unroll
                    for (int j = 0; j < 8; ++j) { ss += v[j] * v[j]; v[j] *= g[j]; }
                    ss += __shfl_xor(ss, 16); ss += __shfl_xor(ss, 32);
                    if (fq == 0) SSQ[(size_t)row * 16 + (pn - 18) * 8 + bj * 4 + wc] = ss;
                    *(u32x4*)(CQ + (size_t)row * 384 + c) = pack8(v);
                } else if (wc == 0) {
                    const int c = fq * 8;
                    rope8<32>(v, true, fq < 2, cs_ml + pos * 16 + (fq & 1) * 8);
                    float* orow = row < MP ? out + O_RP + (size_t)row * 32 : out + O_RS + (size_t)(row - MP) * 32;
                    st8f(orow + c, v);
                    *(u32x4*)(KRB + (size_t)kr * 32 + c) = pack8(v);
                }
            EPI_END
        }
    }
};
struct Epi2a {
    static constexpr bool PERM = true, AFTER_DRAIN = false;
    bf16_t* QM; const float* SSQ; const f32x2* cs_ml;
    __device__ __forceinline__ void operator()(const f32x4 (&acc)[2][2][4][2], const Unit& u, int wr, int wc, int fr, int fq) const {
        EPI_ROWS_BEGIN const int pos = tok_pos(row);
            float s = 0.f; { const f32x4* p = (const f32x4*)(SSQ + (size_t)row * 16); const f32x4 a = p[0], b = p[1], c = p[2]; s = (a[0] + a[1] + a[2] + a[3]) + (b[0] + b[1] + b[2] + b[3]) + (c[0] + c[1] + c[2] + c[3]); }
            const float sc = rsqrtf(s * (1.0f / 384.0f) + RMS_EPS) * C2M;
        EPI_COLS_BEGIN
            const int g32 = u.pn * 8 + bj * 4 + wc;
#pragma unroll
            for (int j = 0; j < 8; ++j) v[j] *= sc;
            if (g32 % 3 == 2) rope8<32>(v, true, fq < 2, cs_ml + pos * 16 + (fq & 1) * 8);
            *(u32x4*)(QM + (size_t)row * 768 + c8) = pack8(v);
        EPI_END
    }
};
struct Epi2b {
    static constexpr bool PERM = true, AFTER_DRAIN = false;
    bf16_t *KN, *VM; const float* SSKV;
    __device__ __forceinline__ void operator()(const f32x4 (&acc)[2][2][4][2], const Unit& u, int wr, int wc, int fr, int fq) const {
        EPI_ROWS_BEGIN
            int trow = row; bool isnew = true;
            if (row >= MP) { const int s = row - MP, b = s / TS, t = s - b * TS; isnew = t >= PAST; trow = MP + b * 64 + (t - PAST); }
            float sc = 1.0f;
            if (isnew) { const f32x4* p = (const f32x4*)(SSKV + (size_t)trow * 8); const f32x4 a = p[0], b = p[1]; sc = rsqrtf(((a[0] + a[1] + a[2] + a[3]) + (b[0] + b[1] + b[2] + b[3])) * (1.0f / 256.0f) + RMS_EPS); }
        EPI_COLS_BEGIN
#pragma unroll
            for (int j = 0; j < 8; ++j) v[j] *= sc;
            if (u.pn < 2) *(u32x4*)(KN + (size_t)row * 512 + c8) = pack8(v);
            else *(u32x4*)(VM + (size_t)row * 512 + (c8 - 512)) = pack8(v);
        EPI_END
    }
};
struct Epi3a {
    static constexpr bool PERM = true, AFTER_DRAIN = false;
    float* T; const bf16_t* G;
    __device__ __forceinline__ void operator()(const f32x4 (&acc)[2][2][4][2], const Unit& u, int wr, int wc, int fr, int fq) const {
        EPI_ROWS_BEGIN
        EPI_COLS_BEGIN float g[8]; unpack8(*(const u32x4*)(G + (size_t)row * 2048 + c8), g);
#pragma unroll
            for (int j = 0; j < 8; ++j) v[j] *= g[j];
            st8f(T + (size_t)row * 1024 + c8, v);
        EPI_END
    }
};
struct Epi3b {
    static constexpr bool PERM = true, AFTER_DRAIN = false;
    const float* T; const bf16_t* G; bf16_t* MM;
    __device__ __forceinline__ void operator()(const f32x4 (&acc)[2][2][4][2], const Unit& u, int wr, int wc, int fr, int fq) const {
        EPI_ROWS_BEGIN
        EPI_COLS_BEGIN float g[8], t[8]; unpack8(*(const u32x4*)(G + (size_t)row * 2048 + 1024 + c8), g); ld8f(T + (size_t)row * 1024 + c8, t);
#pragma unroll
            for (int j = 0; j < 8; ++j) v[j] = t[j] + v[j] * g[j];
            *(u32x4*)(MM + (size_t)row * 1024 + c8) = pack8(v);
        EPI_END
    }
};
struct Epi4 {
    static constexpr bool PERM = true, AFTER_DRAIN = false;
    const float *xp, *xs; float* Y; float* SSY;
    __device__ __forceinline__ void operator()(const f32x4 (&acc)[2][2][4][2], const Unit& u, int wr, int wc, int fr, int fq) const {
        EPI_ROWS_BEGIN const float* xr = row < MP ? xp + (size_t)row * 1024 : xs + (size_t)(row - MP) * 1024;
        EPI_COLS_BEGIN float x[8]; ld8f(xr + c8, x); float ss = 0.f;
#pragma unroll
            for (int j = 0; j < 8; ++j) { v[j] += x[j]; ss += v[j] * v[j]; }
            ss += __shfl_xor(ss, 16); ss += __shfl_xor(ss, 32);
            if (fq == 0) SSY[(size_t)row * 32 + u.pn * 8 + bj * 4 + wc] = ss;
            st8f(Y + (size_t)row * 1024 + c8, v);
        EPI_END
    }
};

struct SchedGrid {
    pg8::StaticOrder so; int nt;
    __device__ __forceinline__ bool next(int i, Unit& u) const { if (!so.next(i, u)) return false; u.src = 0; u.nt = nt; return true; }
    __device__ __forceinline__ void a_ready(const Unit&) const {}
    __device__ __forceinline__ void done(const Unit&) const {}
};
struct SchedP2 {
    int G, c;
    static constexpr int NA = (MT / 256) * 3, NBU = (KR / 256) * 4;
    __device__ __forceinline__ bool next(int i, Unit& u) const {
        const int j = i * G + c; if (j >= NA + NBU) return false;
        if (j < NA) { u.pm = j / 3; u.pn = j % 3; u.src = 0; u.nt = 6; } else { const int k = j - NA; u.pm = k >> 2; u.pn = k & 3; u.src = 1; u.nt = 4; }
        return true; }
    __device__ __forceinline__ void a_ready(const Unit&) const {}
    __device__ __forceinline__ void done(const Unit&) const {}
};
struct SchedTwoPass {
    pg8::StaticOrder so; int nt;
    __device__ __forceinline__ bool next(int i, Unit& u) const { if (!so.next(i >> 1, u)) return false; u.src = i & 1; u.nt = nt; return true; }
    __device__ __forceinline__ void a_ready(const Unit&) const {}
    __device__ __forceinline__ void done(const Unit&) const {}
};
struct Epi2 {
    static constexpr bool PERM = true, AFTER_DRAIN = false;
    Epi2a ea; Epi2b eb;
    __device__ __forceinline__ void operator()(const f32x4 (&acc)[2][2][4][2], const Unit& u, int wr, int wc, int fr, int fq) const { if (u.src == 0) ea(acc, u, wr, wc, fr, fq); else eb(acc, u, wr, wc, fr, fq); }
};
struct Epi3 {
    static constexpr bool PERM = true, AFTER_DRAIN = false;
    Epi3a ea; Epi3b eb;
    __device__ __forceinline__ void operator()(const f32x4 (&acc)[2][2][4][2], const Unit& u, int wr, int wc, int fr, int fq) const {
        if (u.src == 0) { ea(acc, u, wr, wc, fr, fq); asm volatile("s_waitcnt vmcnt(0)" ::: "memory"); } else eb(acc, u, wr, wc, fr, fq); }
};

__device__ __forceinline__ int win_dst(int n) {
    if (n < 2048) return n;
    if (n < 2432) return n - 2048 + 4608;
    if (n < 2688) return n - 2432 + 5120;
    if (n < 2720) return n - 2688 + 4992;
    if (n < 3232) return n - 2720 + 2048;
    return n - 3232 + 2560;
}
__device__ __forceinline__ void transpose_item(const float* __restrict__ W, int K, int N, bf16_t* WT, int k0, int n0, int drow0, LAS float* scr, int lane) {
#pragma unroll 8
    for (int i = 0; i < 32; ++i) { const int kk = 2 * i + (lane >> 5); scr[kk * 33 + (lane & 31)] = W[(size_t)(k0 + kk) * N + n0 + (lane & 31)]; }
    asm volatile("s_waitcnt lgkmcnt(0)" ::: "memory");
    const int c = lane & 7;
#pragma unroll
    for (int j = 0; j < 4; ++j) { const int n = (lane >> 3) + 8 * j; const LAS float* s = scr + (8 * c) * 33 + n;
        u32x4 o; o.x = pk2(s[0 * 33], s[1 * 33]); o.y = pk2(s[2 * 33], s[3 * 33]); o.z = pk2(s[4 * 33], s[5 * 33]); o.w = pk2(s[6 * 33], s[7 * 33]);
        *(u32x4*)(WT + (size_t)(drow0 + n) * K + k0 + 8 * c) = o; }
    asm volatile("s_waitcnt lgkmcnt(0)" ::: "memory");
}
__device__ __forceinline__ void sincos_acc(float angf, float& c, float& s) {
    const double x = (double)angf; const double n = __builtin_rint(x * 0.63661977236758134308);
    const double r = __builtin_fma(-n, 1.5707963267948966192, x) - n * 6.123233995736766e-17; const double r2 = r * r;
    double sp = -1.0 / 1307674368000.0; sp = sp * r2 + 1.0 / 6227020800.0; sp = sp * r2 - 1.0 / 39916800.0; sp = sp * r2 + 1.0 / 362880.0; sp = sp * r2 - 1.0 / 5040.0; sp = sp * r2 + 1.0 / 120.0; sp = sp * r2 - 1.0 / 6.0; sp = sp * r2 + 1.0; sp *= r;
    double cp = 1.0 / 20922789888000.0; cp = cp * r2 - 1.0 / 87178291200.0; cp = cp * r2 + 1.0 / 479001600.0; cp = cp * r2 - 1.0 / 3628800.0; cp = cp * r2 + 1.0 / 40320.0; cp = cp * r2 - 1.0 / 720.0; cp = cp * r2 + 1.0 / 24.0; cp = cp * r2 - 0.5; cp = cp * r2 + 1.0;
    const int q = ((int)n) & 3;
    const double ss = (q == 0) ? sp : (q == 1) ? cp : (q == 2) ? -sp : -cp;
    const double cc = (q == 0) ? cp : (q == 1) ? -sp : (q == 2) ? -cp : sp;
    c = (float)cc; s = (float)ss;
}
__device__ __forceinline__ void p0_prologue(const Args& a, LAS unsigned char* lds) {
    const int tid = threadIdx.x, lane = tid & 63, wave = tid >> 6;
    const int G = gridDim.x, gw = blockIdx.x * NWAVES + wave, NGW = G * NWAVES, gt = blockIdx.x * NTHREADS + tid, NGT = G * NTHREADS;
    unsigned char* ws = a.ws;
    LAS float* scr = (LAS float*)(lds + wave * 8704);
    if (blockIdx.x == 0 && wave == 0) {
        if (lane < 16) ((unsigned*)(ws + WS_CTL))[lane] = 0u;
        const float* L = a.in[9];
        const float sa = wave_sum(L[lane] * L[64 + lane]), sb = wave_sum(L[128 + lane] * L[192 + lane]);
        if (lane == 0) ((float*)(ws + WS_LAM))[0] = expf(sa) - expf(sb) + LAM_INIT;
    }
    for (int i = gt; i < 4096 * 8; i += NGT) { const int pos = i >> 3, j = i & 7; float c, s; sincos_acc((float)pos * c_inv_da[j], c, s); ((f32x2*)(ws + WS_ROPE_DA))[i] = (f32x2){c, s}; }
    for (int i = gt; i < 4096 * 16; i += NGT) { const int pos = i >> 4, j = i & 15; float c, s; sincos_acc((float)pos * c_inv_ml[j], c, s); ((f32x2*)(ws + WS_ROPE_ML))[i] = (f32x2){c, s}; }
    constexpr int I_IN = 16 * 165, I_UQ = 6 * 24, I_UK = 4 * 16, I_UV = 4 * 16, I_A = 8 * 32, I_B = 8 * 32, I_O = 16 * 32;
    constexpr int NITEMS = I_IN + I_UQ + I_UK + I_UV + I_A + I_B + I_O;
    for (int it = gw; it < NITEMS; it += NGW) {
        int r = it;
        if (r < I_IN) { const int kb = r / 165, nb = r % 165; transpose_item(a.in[7], 1024, 5280, (bf16_t*)(ws + WS_WIN), kb * 64, nb * 32, win_dst(nb * 32), scr, lane); continue; } r -= I_IN;
        if (r < I_UQ) { const int kb = r / 24, nb = r % 24; transpose_item(a.in[13], 384, 768, (bf16_t*)(ws + WS_WUQ), kb * 64, nb * 32, nb * 32, scr, lane); continue; } r -= I_UQ;
        if (r < I_UK) { const int kb = r / 16, nb = r % 16; transpose_item(a.in[14], 384, 512, (bf16_t*)(ws + WS_WUKV), kb * 64, nb * 32, nb * 32, scr, lane); continue; } r -= I_UK;
        if (r < I_UV) { const int kb = r / 16, nb = r % 16; transpose_item(a.in[15], 384, 512, (bf16_t*)(ws + WS_WUKV), kb * 64, nb * 32, 512 + nb * 32, scr, lane); continue; } r -= I_UV;
        if (r < I_A) { const int kb = r / 32, nb = r % 32; transpose_item(a.in[16], 512, 1024, (bf16_t*)(ws + WS_WA), kb * 64, nb * 32, nb * 32, scr, lane); continue; } r -= I_A;
        if (r < I_B) { const int kb = r / 32, nb = r % 32; transpose_item(a.in[17], 512, 1024, (bf16_t*)(ws + WS_WB), kb * 64, nb * 32, nb * 32, scr, lane); continue; } r -= I_B;
        { const int kb = r / 32, nb = r % 32; transpose_item(a.in[18], 1024, 1024, (bf16_t*)(ws + WS_WOUT), kb * 64, nb * 32, nb * 32, scr, lane); }
    }
    { u32x4* z = (u32x4*)((bf16_t*)(ws + WS_WIN) + (size_t)5024 * 1024); for (int i = gt; i < 96 * 1024 / 8; i += NGT) z[i] = (u32x4){0u, 0u, 0u, 0u}; }
    {
        const float* gp = a.in[6]; f32x4 g[4];
#pragma unroll
        for (int j = 0; j < 4; ++j) g[j] = ((const f32x4*)gp)[lane + 64 * j];
        for (int m = gw; m < MT; m += NGW) {
            const float* xr = m < MP ? a.in[0] + (size_t)m * 1024 : a.in[1] + (size_t)(m - MP) * 1024;
            f32x4 v[4]; float s = 0.f;
#pragma unroll
            for (int j = 0; j < 4; ++j) { v[j] = ((const f32x4*)xr)[lane + 64 * j]; s += (v[j][0] * v[j][0] + v[j][1] * v[j][1]) + (v[j][2] * v[j][2] + v[j][3] * v[j][3]); }
            const float rstd = rsqrtf(wave_sum(s) * (1.0f / 1024.0f) + RMS_EPS);
            u32x2* o = (u32x2*)((bf16_t*)(ws + WS_XN) + (size_t)m * 1024);
#pragma unroll
            for (int j = 0; j < 4; ++j) { u32x2 w; w.x = pk2(v[j][0] * rstd * g[j][0], v[j][1] * rstd * g[j][1]); w.y = pk2(v[j][2] * rstd * g[j][2], v[j][3] * rstd * g[j][3]); o[lane + 64 * j] = w; }
        }
    }
    for (int i = gt; i < DECB * PAST * 512 / 4; i += NGT) {
        const int e = i * 4, bt = e >> 9, c = e & 511, b = bt >> 10, t = bt & 1023; const size_t d = (size_t)(MP + b * TS + t) * 512 + c;
        const f32x4 k = ((const f32x4*)a.in[2])[i], v = ((const f32x4*)a.in[3])[i];
        *(u32x2*)((bf16_t*)(ws + WS_KA) + d) = (u32x2){pk2(k[0], k[1]), pk2(k[2], k[3])};
        *(u32x2*)((bf16_t*)(ws + WS_VA) + d) = (u32x2){pk2(v[0], v[1]), pk2(v[2], v[3])};
    }
    for (int i = gt; i < DECB * PAST * 256 / 4; i += NGT) {
        const int e = i * 4, bt = e >> 8, c = e & 255, b = bt >> 10, t = bt & 1023; const size_t d = (size_t)(MP + b * TS + t) * 384 + c;
        const f32x4 k = ((const f32x4*)a.in[4])[i];
        *(u32x2*)((bf16_t*)(ws + WS_CALL) + d) = (u32x2){pk2(k[0], k[1]), pk2(k[2], k[3])};
    }
    for (int i = gt; i < DECB * PAST * 32 / 4; i += NGT) {
        const int e = i * 4, bt = e >> 5, c = e & 31, b = bt >> 10, t = bt & 1023; const size_t d = (size_t)(MP + b * TS + t) * 32 + c;
        const f32x4 k = ((const f32x4*)a.in[5])[i];
        *(u32x2*)((bf16_t*)(ws + WS_KR) + d) = (u32x2){pk2(k[0], k[1]), pk2(k[2], k[3])};
    }
}

constexpr int A_KBUF = 16384, A_VBUF = 16384, A_BUF = A_KBUF + A_VBUF;
constexpr int A_X = 2 * A_BUF, A_WS = A_X + 65536;
constexpr float A_THR = 8.0f;
#define MFMA32(a, b, c) __builtin_amdgcn_mfma_f32_32x32x16_bf16(a, b, c, 0, 0, 0)
typedef short v4i16_t __attribute__((ext_vector_type(4)));
__device__ __forceinline__ s16x4 vtr(const LAS unsigned char* p) { return __builtin_bit_cast(s16x4, __builtin_amdgcn_ds_read_tr16_b64_v4i16((LAS v4i16_t*)p)); }

struct AUnit { int qrow0, kbase, nt, nrow, h; };

template <bool DA>
__device__ __forceinline__ void attn_unit(LAS unsigned char* lds, const AUnit U, const Args& a) {
    constexpr int DQK = DA ? 64 : 96, DV = DA ? 128 : 64, ND0 = DQK / 16, NDB = DV / 32;
    constexpr int KCH = DA ? 16 : 12;
    constexpr int NKP = KCH * 64 / 512 + ((KCH * 64) % 512 ? 1 : 0), NVP = NDB * 256 / 512 + ((NDB * 256) % 512 ? 1 : 0);
    const int tid = threadIdx.x, lane = tid & 63, r32 = lane & 31, hi = lane >> 5; const int wid = __builtin_amdgcn_readfirstlane(tid >> 6);
    unsigned char* ws = a.ws;
    const int wq = DA ? (wid & 3) : wid, comp = DA ? (wid >> 2) : 0;
    const int wrow = wq * 32; const bool active = wrow < U.nrow;
    const int myrow0 = U.qrow0 + wrow;
    const int my_nt = active ? (tok_pos(myrow0) >> 6) + 1 : 0;
    bf16x8 qr[ND0];
    {
        const bf16_t* Qb = DA ? (const bf16_t*)(ws + WS_QA) + (size_t)(myrow0 + r32) * 512 + U.h * 128 + comp * 64 : (const bf16_t*)(ws + WS_QM) + (size_t)(myrow0 + r32) * 768 + U.h * 96;
#pragma unroll
        for (int d0 = 0; d0 < ND0; ++d0) qr[d0] = active ? *(const bf16x8*)(Qb + d0 * 16 + hi * 8) : (bf16x8){0, 0, 0, 0, 0, 0, 0, 0};
    }
    const bf16_t* kp[NKP]; int kl[NKP]; bool kok[NKP]; const bf16_t* vp[NVP]; int vl[NVP];
#pragma unroll
    for (int i = 0; i < NKP; ++i) { const int p = tid + 512 * i, row = p & 63, ch = p >> 6; kok[i] = ch < KCH; kl[i] = ch * 1024 + row * 16;
        if (DA) kp[i] = (const bf16_t*)(ws + WS_KA) + (size_t)(U.kbase + row) * 512 + U.h * 128 + ch * 8;
        else kp[i] = ch < 8 ? (const bf16_t*)(ws + WS_KN) + (size_t)(U.kbase + row) * 512 + U.h * 64 + ch * 8 : (const bf16_t*)(ws + WS_KR) + (size_t)(U.kbase + row) * 32 + (ch - 8) * 8; }
    const int kstep = DA ? 64 * 512 : 0;
#pragma unroll
    for (int i = 0; i < NVP; ++i) { const int p = tid + 512 * i, sub = p & 3, row = (p >> 2) & 63, db = p >> 8; vl[i] = db * 4096 + row * 64 + sub * 16;
        vp[i] = DA ? (const bf16_t*)(ws + WS_VA) + (size_t)(U.kbase + row) * 512 + U.h * 128 + db * 32 + sub * 8 : (const bf16_t*)(ws + WS_VM) + (size_t)(U.kbase + row) * 512 + U.h * 64 + db * 32 + sub * 8; }
    u32x4 rk[NKP], rv[NVP];
    auto stage_load = [&](int t) {
#pragma unroll
        for (int i = 0; i < NKP; ++i) if (kok[i]) { const int p = tid + 512 * i, ch = p >> 6; const size_t off = DA ? (size_t)t * 64 * 512 : (ch < 8 ? (size_t)t * 64 * 512 : (size_t)t * 64 * 32); rk[i] = *(const u32x4*)(kp[i] + off); }
#pragma unroll
        for (int i = 0; i < NVP; ++i) rv[i] = *(const u32x4*)(vp[i] + (size_t)t * 64 * 512);
    };
    auto stage_write = [&](int buf) {
        LAS unsigned char* kb = lds + buf * A_BUF; LAS unsigned char* vb = kb + A_KBUF;
#pragma unroll
        for (int i = 0; i < NKP; ++i) if (kok[i]) *(LAS u32x4*)(kb + kl[i]) = rk[i];
#pragma unroll
        for (int i = 0; i < NVP; ++i) *(LAS u32x4*)(vb + vl[i]) = rv[i];
    };
    (void)kstep;
    LAS float* wsf = (LAS float*)(lds + A_WS) + wid * 64;
    const int koff = hi * 1024 + r32 * 16 + (DA ? comp * 8192 : 0);
    const int voff = ((lane >> 4) & 1) * 32 + (lane & 3) * 8 + (4 * hi + ((lane & 15) >> 2)) * 64;
    f32x16 o[NDB];
#pragma unroll
    for (int d = 0; d < NDB; ++d) o[d] = f32x16{};
    float mrow = 0.f, lrow = 0.f;
    stage_load(0); stage_write(0); __syncthreads();
    for (int t = 0; t < U.nt; ++t) {
        if (t + 1 < U.nt) stage_load(t + 1);
        if (t < my_nt) {
            const LAS unsigned char* kb = lds + (t & 1) * A_BUF + koff; const LAS unsigned char* vb = lds + (t & 1) * A_BUF + A_KBUF + voff;
            f32x16 p0 = f32x16{}, p1 = f32x16{};
#pragma unroll
            for (int d0 = 0; d0 < ND0; ++d0) { const bf16x8 k0 = *(const LAS bf16x8*)(kb + d0 * 2048), k1 = *(const LAS bf16x8*)(kb + d0 * 2048 + 512); p0 = MFMA32(k0, qr[d0], p0); p1 = MFMA32(k1, qr[d0], p1); }
            float rm = fmaxf(p0[0], p1[0]);
#pragma unroll
            for (int r = 1; r < 16; ++r) rm = fmaxf(rm, fmaxf(p0[r], p1[r]));
            rm = fmaxf(rm, __shfl_xor(rm, 32));
            if (t == 0) mrow = rm;
            else if (__any(rm > mrow + A_THR)) {
                const float mn = fmaxf(mrow, rm), al = exp2f(mrow - mn); mrow = mn; lrow *= al;
                if (hi == 0) wsf[r32] = al;
                asm volatile("s_waitcnt lgkmcnt(0)" ::: "memory");
#pragma unroll
                for (int r = 0; r < 16; ++r) { const float f = wsf[crow(r, hi)];
#pragma unroll
                    for (int d = 0; d < NDB; ++d) o[d][r] *= f; }
                asm volatile("s_waitcnt lgkmcnt(0)" ::: "memory");
            }
            float sacc = 0.f;
#pragma unroll
            for (int r = 0; r < 16; ++r) { p0[r] = __builtin_amdgcn_exp2f(p0[r] - mrow); p1[r] = __builtin_amdgcn_exp2f(p1[r] - mrow); sacc += p0[r] + p1[r]; }
            lrow += sacc;
            bf16x8 pw[4];
            pw[0] = __builtin_bit_cast(bf16x8, (u32x4){pk2(p0[0], p0[1]), pk2(p0[2], p0[3]), pk2(p0[4], p0[5]), pk2(p0[6], p0[7])});
            pw[1] = __builtin_bit_cast(bf16x8, (u32x4){pk2(p0[8], p0[9]), pk2(p0[10], p0[11]), pk2(p0[12], p0[13]), pk2(p0[14], p0[15])});
            pw[2] = __builtin_bit_cast(bf16x8, (u32x4){pk2(p1[0], p1[1]), pk2(p1[2], p1[3]), pk2(p1[4], p1[5]), pk2(p1[6], p1[7])});
            pw[3] = __builtin_bit_cast(bf16x8, (u32x4){pk2(p1[8], p1[9]), pk2(p1[10], p1[11]), pk2(p1[12], p1[13]), pk2(p1[14], p1[15])});
#pragma unroll
            for (int d = 0; d < NDB; ++d)
#pragma unroll
                for (int ks = 0; ks < 4; ++ks) { const s16x4 lo = vtr(vb + d * 4096 + ks * 1024), hh = vtr(vb + d * 4096 + ks * 1024 + 512);
                    const bf16x8 vf = (bf16x8){lo[0], lo[1], lo[2], lo[3], hh[0], hh[1], hh[2], hh[3]};
                    o[d] = MFMA32(pw[ks], vf, o[d]); }
        }
        if (t + 1 < U.nt) stage_write((t + 1) & 1);
        __syncthreads();
    }
    lrow += __shfl_xor(lrow, 32);
    if (hi == 0) wsf[r32] = active ? 1.0f / lrow : 0.f;
    asm volatile("s_waitcnt lgkmcnt(0)" ::: "memory");
    float il[16];
#pragma unroll
    for (int r = 0; r < 16; ++r) il[r] = wsf[crow(r, hi)];
    asm volatile("s_waitcnt lgkmcnt(0)" ::: "memory");
    if (DA) {
        LAS float* X = (LAS float*)(lds + A_X) + (size_t)wq * (NDB * 16 * 64);
        if (comp == 1) {
#pragma unroll
            for (int d = 0; d < NDB; ++d)
#pragma unroll
                for (int r = 0; r < 16; ++r) X[(d * 16 + r) * 64 + lane] = o[d][r] * il[r];
        }
        __syncthreads();
        if (comp == 0 && active) {
            const float lam = ((const float*)(ws + WS_LAM))[0];
            float ss[16];
#pragma unroll
            for (int r = 0; r < 16; ++r) { ss[r] = 0.f;
#pragma unroll
                for (int d = 0; d < NDB; ++d) { const float x = o[d][r] * il[r] - lam * X[(d * 16 + r) * 64 + lane]; o[d][r] = x; ss[r] += x * x; } }
#pragma unroll
            for (int r = 0; r < 16; ++r) { float s = ss[r]; s += __shfl_xor(s, 1); s += __shfl_xor(s, 2); s += __shfl_xor(s, 4); s += __shfl_xor(s, 8); s += __shfl_xor(s, 16); ss[r] = rsqrtf(s * (1.0f / 128.0f) + RMS_EPS) * (1.0f - LAM_INIT); }
            const float* gh = a.in[10];
            const bf16_t* sz = (const bf16_t*)(ws + WS_SZA); bf16_t* ua = (bf16_t*)(ws + WS_UA);
#pragma unroll
            for (int d = 0; d < NDB; ++d) { const int col = U.h * 128 + d * 32 + r32; const float g = gh[d * 32 + r32];
#pragma unroll
                for (int r = 0; r < 16; ++r) { const size_t idx = (size_t)(myrow0 + crow(r, hi)) * 512 + col; ua[idx] = (bf16_t)(pk2(o[d][r] * ss[r] * g * bf2f(sz[idx]), 0.f) & 0xffffu); } }
        }
        __syncthreads();
    } else {
        if (active) {
            const bf16_t* sz = (const bf16_t*)(ws + WS_SZB); bf16_t* ub = (bf16_t*)(ws + WS_UB);
#pragma unroll
            for (int d = 0; d < NDB; ++d) { const int col = U.h * 64 + d * 32 + r32;
#pragma unroll
                for (int r = 0; r < 16; ++r) { const size_t idx = (size_t)(myrow0 + crow(r, hi)) * 512 + col; ub[idx] = (bf16_t)(pk2(o[d][r] * il[r] * bf2f(sz[idx]), 0.f) & 0xffffu); } }
        }
    }
}
constexpr int A_ITEMS_P = 4096, A_ITEMS = A_ITEMS_P + 32 + 64;
__device__ __forceinline__ void attn_phase(LAS unsigned char* lds, const Args& a, int cw) {
    unsigned* ctr = (unsigned*)(a.ws + WS_CTL) + cw;
    volatile LAS int* misc = (volatile LAS int*)(lds + LDS_MISC);
    for (;;) {
        if (threadIdx.x == 0) misc[0] = (int)atomicAdd(ctr, 1u);
        __syncthreads();
        const int it = misc[0];
        __syncthreads();
        if (it >= A_ITEMS) break;
        AUnit U;
        if (it < A_ITEMS_P) {
            const int r = it >> 7, j = it & 127;
            if (j < 64) { const int b = j >> 2, qb = 31 - r; U.h = j & 3; U.qrow0 = b * SEQ + qb * 128; U.kbase = b * SEQ; U.nt = 2 * qb + 2; U.nrow = 128; attn_unit<true>(lds, U, a); }
            else { const int bh = 2 * (j - 64) + (r & 1), b = bh >> 3, qb = 15 - (r >> 1); U.h = bh & 7; U.qrow0 = b * SEQ + qb * 256; U.kbase = b * SEQ; U.nt = 4 * qb + 4; U.nrow = 256; attn_unit<false>(lds, U, a); }
        } else if (it < A_ITEMS_P + 32) {
            const int j = it - A_ITEMS_P, b = j >> 2; U.h = j & 3; U.qrow0 = MP + b * 64; U.kbase = MP + b * TS; U.nt = 17; U.nrow = 64; attn_unit<true>(lds, U, a);
        } else {
            const int j = it - A_ITEMS_P - 32, b = j >> 3; U.h = j & 7; U.qrow0 = MP + b * 64; U.kbase = MP + b * TS; U.nt = 17; U.nrow = 64; attn_unit<false>(lds, U, a);
        }
    }
}

__global__ void __launch_bounds__(NTHREADS, 2) mega_fwd(Args a) {
    extern __shared__ __attribute__((aligned(16))) unsigned char lds_raw[];
    LAS unsigned char* lds = (LAS unsigned char*)lds_raw;
    cg::grid_group grid = cg::this_grid();
    unsigned char* ws = a.ws; float* out = a.out;
    const int G = gridDim.x, bid = blockIdx.x, tid = threadIdx.x, lane = tid & 63, wave = tid >> 6;
    const int lo = a.ph_lo, hi = a.ph_hi;
#define IN(k) (lo <= (k) && (k) < hi)
#define SEAM(k) do { if (IN(k) && IN((k) + 1)) grid.sync(); } while (0)
    const f32x2* cs_da = (const f32x2*)(ws + WS_ROPE_DA); const f32x2* cs_ml = (const f32x2*)(ws + WS_ROPE_ML);
    if (IN(0)) p0_prologue(a, lds);
    SEAM(0);
    if (IN(1)) {
        Epi1 E{ws, out, a.in[8], a.in[11], a.in[12]};
        pg8::Gemm g{(const bf16_t*)(ws + WS_XN), nullptr, (const bf16_t*)(ws + WS_WIN), nullptr, 1024};
        SchedGrid S; S.so.init(MT, NIN, G, bid); S.nt = 16;
        for (int rep = 0; rep < (PROBE_REP == 1 ? 2 : 1); ++rep)
        pg8::gemm_phase<Epi1, SchedGrid, true, true>(lds, g, S, E);
    }
    SEAM(1);
    if (IN(2)) {
        Epi2a Ea{(bf16_t*)(ws + WS_QM), (const float*)(ws + WS_SSQ), cs_ml};
        Epi2b Eb{(bf16_t*)(ws + WS_KN), (bf16_t*)(ws + WS_VM), (const float*)(ws + WS_SSKV)};
        pg8::Gemm g{(const bf16_t*)(ws + WS_CQ), (const bf16_t*)(ws + WS_CALL), (const bf16_t*)(ws + WS_WUQ), (const bf16_t*)(ws + WS_WUKV), 384};
        SchedP2 S{G, bid}; Epi2 E{Ea, Eb};
        pg8::gemm_phase<Epi2, SchedP2, true, true>(lds, g, S, E);
        for (int m = bid * NWAVES + wave; m < MT; m += G * NWAVES) {
            const float* p = (const float*)(ws + WS_SSKV) + (size_t)m * 8; float s = 0.f;
#pragma unroll
            for (int j = 0; j < 8; ++j) s += p[j];
            const float rstd = rsqrtf(s * (1.0f / 256.0f) + RMS_EPS);
            f32x4* r = (f32x4*)(m < MP ? out + O_LP + (size_t)m * 256 : out + O_LS + (size_t)(m - MP) * 256) + lane;
            f32x4 v = *r; v = v * rstd; *r = v;
        }
    }
    SEAM(2);
    if (IN(3)) { attn_phase(lds, a, 0); if (PROBE_REP == 3) { __syncthreads(); attn_phase(lds, a, 1); } }
    SEAM(3);
    if (IN(4)) {
        Epi3a Ea{(float*)(ws + WS_T), (const bf16_t*)(out + O_Y)};
        Epi3b Eb{(const float*)(ws + WS_T), (const bf16_t*)(out + O_Y), (bf16_t*)(ws + WS_MM)};
        pg8::Gemm g{(const bf16_t*)(ws + WS_UA), (const bf16_t*)(ws + WS_UB), (const bf16_t*)(ws + WS_WA), (const bf16_t*)(ws + WS_WB), 512};
        SchedTwoPass S; S.so.init(MT, 1024, G, bid); S.nt = 8; Epi3 E{Ea, Eb};
        pg8::gemm_phase<Epi3, SchedTwoPass, true, true>(lds, g, S, E);
    }
    SEAM(4);
    if (IN(5)) {
        Epi4 E{a.in[0], a.in[1], out + O_Y, (float*)(ws + WS_SSY)};
        pg8::Gemm g{(const bf16_t*)(ws + WS_MM), nullptr, (const bf16_t*)(ws + WS_WOUT), nullptr, 1024};
        SchedGrid S; S.so.init(MT, 1024, G, bid); S.nt = 16;
        pg8::gemm_phase<Epi4, SchedGrid, true, true>(lds, g, S, E);
    }
    SEAM(5);
    if (IN(6)) {
        f32x4 g[4];
#pragma unroll
        for (int j = 0; j < 4; ++j) g[j] = ((const f32x4*)a.in[19])[lane + 64 * j];
        for (int m = bid * NWAVES + wave; m < MT; m += G * NWAVES) {
            const float* p = (const float*)(ws + WS_SSY) + (size_t)m * 32;
            const float s = wave_sum(lane < 32 ? p[lane] : 0.f);
            const float rstd = rsqrtf(s * (1.0f / 1024.0f) + RMS_EPS);
            f32x4* r = (f32x4*)(out + O_Y + (size_t)m * 1024);
#pragma unroll
            for (int j = 0; j < 4; ++j) { f32x4 v = r[lane + 64 * j]; v = v * rstd * g[j]; r[lane + 64 * j] = v; }
        }
    }
#undef IN
#undef SEAM
}

extern "C" void kernel_launch(void* const* d_in, const int* in_sizes, int n_in, void* d_out, int out_size, void* d_ws, size_t ws_size, hipStream_t stream) {
    static int grid = 0;
    if (grid == 0) {
        if (n_in != 20 || (size_t)out_size != O_END || ws_size < WS_END) { fprintf(stderr, "kernel_launch: unexpected shapes (n_in %d out %d ws %zu)\n", n_in, out_size, ws_size); grid = -1; return; }
        int dev = 0, cus = 0, per_cu = 0;
        hipGetDevice(&dev); hipDeviceGetAttribute(&cus, hipDeviceAttributeMultiprocessorCount, dev);
        if (hipFuncSetAttribute((const void*)mega_fwd, hipFuncAttributeMaxDynamicSharedMemorySize, LDS_BYTES) != hipSuccess) { fprintf(stderr, "kernel_launch: hipFuncSetAttribute failed\n"); grid = -1; return; }
        if (hipOccupancyMaxActiveBlocksPerMultiprocessor(&per_cu, (const void*)mega_fwd, NTHREADS, LDS_BYTES) != hipSuccess || per_cu < 1) { fprintf(stderr, "kernel_launch: occupancy query says %d\n", per_cu); (void)hipGetLastError(); grid = -1; return; }
        grid = cus;
        if (grid > cus * per_cu) grid = cus * per_cu;
    }
    if (grid < 0) return;
    Args a{};
    for (int i = 0; i < 20; ++i) a.in[i] = (const float*)d_in[i];
    a.out = (float*)d_out; a.ws = (unsigned char*)d_ws;
#if MK_N_LAUNCHES == 1
    a.ph_lo = 0; a.ph_hi = 7;
    void* args[] = {&a};
    hipError_t e = hipLaunchCooperativeKernel((const void*)mega_fwd, dim3(grid), dim3(NTHREADS), args, LDS_BYTES, stream);
    if (e != hipSuccess) fprintf(stderr, "cooperative launch failed: %s (grid %d)\n", hipGetErrorString(e), grid);
#else
    for (int p = 0; p < 7; ++p) { a.ph_lo = p; a.ph_hi = p + 1; hipLaunchKernelGGL(mega_fwd, dim3(grid), dim3(NTHREADS), LDS_BYTES, stream, a); }
#endif
}
```

```cpp
#include <hip/hip_runtime.h>
#include <hip/hip_cooperative_groups.h>
#include <cstdio>
#include <cstdint>
namespace cg = cooperative_groups;

#ifndef MK_N_LAUNCHES
#define MK_N_LAUNCHES 1
#endif

#ifndef PROBE_REP
#define PROBE_REP -1
#endif
#define LAS __attribute__((address_space(3)))
typedef unsigned short bf16_t;
typedef short bf16x8 __attribute__((ext_vector_type(8)));
typedef short s16x4 __attribute__((ext_vector_type(4)));
typedef float f32x2 __attribute__((ext_vector_type(2)));
typedef float f32x4 __attribute__((ext_vector_type(4)));
typedef float f32x16 __attribute__((ext_vector_type(16)));
typedef unsigned u32x2 __attribute__((ext_vector_type(2)));
typedef unsigned u32x4 __attribute__((ext_vector_type(4)));
typedef __bf16 bf16x2_t __attribute__((ext_vector_type(2)));

constexpr int DM = 1024, NB = 16, SEQ = 4096, DECB = 8, DECS = 64, PAST = 1024;
constexpr int MP = NB * SEQ;
constexpr int MS = DECB * DECS;
constexpr int MT = MP + MS;
constexpr int TS = PAST + DECS;
constexpr int KR = MP + DECB * TS;
constexpr int NIN = 5376;
constexpr float RMS_EPS = 1e-6f;
constexpr float LOG2E = 1.4426950408889634f;
constexpr float C2A = 0.125f * LOG2E;
constexpr float C2M = 0.10206207261596575f * LOG2E;
constexpr float LAM_INIT = 0.2f;
constexpr size_t O_Y = 0;
constexpr size_t O_KP = (size_t)MT * 1024;
constexpr size_t O_VP = O_KP + (size_t)MP * 512;
constexpr size_t O_LP = O_VP + (size_t)MP * 512;
constexpr size_t O_RP = O_LP + (size_t)MP * 256;
constexpr size_t O_KS = O_RP + (size_t)MP * 32;
constexpr size_t O_VS = O_KS + (size_t)MS * 512;
constexpr size_t O_LS = O_VS + (size_t)MS * 512;
constexpr size_t O_RS = O_LS + (size_t)MS * 256;
constexpr size_t O_END = O_RS + (size_t)MS * 32;
constexpr size_t MiB = 1u << 20;
constexpr size_t WS_CTL = 0, WS_LAM = 4096, WS_ROPE_DA = 8192, WS_ROPE_ML = WS_ROPE_DA + 4096 * 8 * 8;
constexpr size_t WS_WIN = 1 * MiB, WS_WUQ = 12 * MiB, WS_WUKV = 13 * MiB, WS_WA = 14 * MiB, WS_WB = 15 * MiB, WS_WOUT = 16 * MiB;
constexpr size_t WS_SSQ = 18 * MiB, WS_SSKV = 23 * MiB, WS_SSY = 26 * MiB;
constexpr size_t WS_XN = 36 * MiB;
constexpr size_t WS_UA = WS_XN, WS_UB = WS_XN + (size_t)MT * 512 * 2;
constexpr size_t WS_QA = 166 * MiB, WS_KA = 231 * MiB, WS_VA = 304 * MiB, WS_SZA = 377 * MiB;
constexpr size_t WS_T = WS_QA;
constexpr size_t WS_SZB = 442 * MiB, WS_CQ = 507 * MiB, WS_CALL = 556 * MiB, WS_KR = 611 * MiB;
constexpr size_t WS_QM = 616 * MiB, WS_KN = 713 * MiB, WS_VM = 786 * MiB;
constexpr size_t WS_MM = WS_QM;
constexpr size_t WS_END = 859 * MiB;
static_assert(WS_XN + (size_t)MT * 1024 * 2 <= WS_QA && WS_T + (size_t)MT * 1024 * 4 <= WS_SZB && WS_MM + (size_t)MT * 1024 * 2 <= WS_VM + (size_t)KR * 512 * 2, "ws map");
static_assert(WS_QA + (size_t)MT * 512 * 2 <= WS_KA && WS_KA + (size_t)KR * 512 * 2 <= WS_VA && WS_VA + (size_t)KR * 512 * 2 <= WS_SZA && WS_SZA + (size_t)MT * 512 * 2 <= WS_SZB, "ws map 2");
static_assert(WS_SZB + (size_t)MT * 512 * 2 <= WS_CQ && WS_CQ + (size_t)MT * 384 * 2 <= WS_CALL && WS_CALL + (size_t)KR * 384 * 2 <= WS_KR && WS_KR + (size_t)KR * 32 * 2 <= WS_QM, "ws map 3");
static_assert(WS_QM + (size_t)MT * 768 * 2 <= WS_KN && WS_KN + (size_t)KR * 512 * 2 <= WS_VM && WS_VM + (size_t)KR * 512 * 2 <= WS_END, "ws map 4");
static_assert(WS_WIN + (size_t)NIN * 1024 * 2 <= WS_WUQ && WS_SSQ + (size_t)MT * 16 * 4 <= WS_SSKV && WS_SSKV + (size_t)MT * 8 * 4 <= WS_SSY && WS_SSY + (size_t)MT * 32 * 4 <= WS_XN, "ws map 5");

constexpr int NTHREADS = 512, NWAVES = 8;
constexpr int LDS_BYTES = 139264;
constexpr int LDS_MISC = 135168;

__constant__ float c_inv_da[8] = {1.0f, 0.1939227432012558f, 0.03760603070259094f, 0.007292664609849453f, 0.0014142135623842478f, 0.00027424818836152554f, 5.318296098266728e-05f, 1.0313386155758053e-05f};
__constant__ float c_inv_ml[16] = {1.0f, 0.44036659598350525f, 0.1939227432012558f, 0.08539710193872452f, 0.03760603070259094f, 0.01656043902039528f, 0.007292664609849453f, 0.0032114458736032248f,
                                   0.0014142135623842478f, 0.000622772378847003f, 0.00027424818836152554f, 0.00012076973507646471f, 5.318296098266728e-05f, 2.34199997066753e-05f, 1.0313386155758053e-05f, 4.541670477919979e-06f};

__device__ __forceinline__ unsigned pk2(float lo, float hi) { f32x2 v = {lo, hi}; bf16x2_t b = __builtin_convertvector(v, bf16x2_t); return __builtin_bit_cast(unsigned, b); }
__device__ __forceinline__ float bflo(unsigned u) { return __builtin_bit_cast(float, u << 16); }
__device__ __forceinline__ float bfhi(unsigned u) { return __builtin_bit_cast(float, u & 0xffff0000u); }
__device__ __forceinline__ float bf2f(bf16_t h) { return __builtin_bit_cast(float, (unsigned)h << 16); }
__device__ __forceinline__ u32x4 pack8(const float* v) { u32x4 w; w.x = pk2(v[0], v[1]); w.y = pk2(v[2], v[3]); w.z = pk2(v[4], v[5]); w.w = pk2(v[6], v[7]); return w; }
__device__ __forceinline__ void unpack8(u32x4 w, float* v) { v[0] = bflo(w.x); v[1] = bfhi(w.x); v[2] = bflo(w.y); v[3] = bfhi(w.y); v[4] = bflo(w.z); v[5] = bfhi(w.z); v[6] = bflo(w.w); v[7] = bfhi(w.w); }
__device__ __forceinline__ int tok_pos(int row) { return row < MP ? (row & (SEQ - 1)) : PAST + ((row - MP) & (DECS - 1)); }
__device__ __forceinline__ int tok_krow(int row) { return row < MP ? row : MP + ((row - MP) >> 6) * TS + PAST + ((row - MP) & 63); }
__device__ __forceinline__ float wave_sum(float v) {
#pragma unroll
    for (int o = 1; o < 64; o <<= 1) v += __shfl_xor(v, o);
    return v;
}
__device__ __forceinline__ float sigmoidf_(float x) { return 1.0f / (1.0f + __expf(-x)); }
__device__ __forceinline__ float siluf_(float x) { return x / (1.0f + __expf(-x)); }
__device__ __forceinline__ int crow(int r, int hi) { return (r & 3) + 8 * (r >> 2) + 4 * hi; }
__host__ __device__ __forceinline__ int perm32(int rho) { const int n = rho >> 4, i = rho & 15; return 8 * (i >> 2) + 4 * n + (i & 3); }

struct Args {
    const float* in[20]; float* out; unsigned char* ws; int ph_lo, ph_hi;
};

namespace pg8 {
#define PG8_LAS __attribute__((address_space(3)))
constexpr int BM = 256, BK = 64, HALF = 128, HTB = HALF * BK * 2  , STAGE_BYTES = 8 * HTB, NXCD = 8, WGM = 8;
__host__ __device__ __forceinline__ int lds_byte(int r, int c) { const int st = (r >> 4) * 2 + (c >> 5), rr = r & 15, cc = c & 31, ob = rr * 64 + cc * 2; return st * 1024 + (ob ^ (((ob >> 9) & 1) << 5)); }
__host__ __device__ __forceinline__ void stage_rc(int b, int& R, int& C) { const int st = b / 1024, sb = b % 1024, swz = sb ^ (((sb >> 9) & 1) << 5); R = (st >> 1) * 16 + swz / 64; C = (st & 1) * 32 + (swz % 64) / 2; }
struct Unit { int pm, pn, src, nt; };
struct Gemm { const bf16_t *A0, *A1, *B0, *B1; int K; };
struct StaticOrder {
    int nM, nN, nwg, G, c;
    __host__ __device__ void init(int M, int N, int G_, int c_) { nM = M / BM; nN = N / BM; nwg = nM * nN; G = G_; c = c_; }
    __host__ __device__ bool next(int i, Unit& u) const {
        const long L = (long)i * G + c; if (L >= nwg) return false;
        int wgid = (int)L; { const int q = nwg / NXCD, r = nwg % NXCD, xcd = wgid % NXCD, off = wgid / NXCD; wgid = (xcd < r ? xcd * (q + 1) : r * (q + 1) + (xcd - r) * q) + off; }
        const int nig = WGM * nN, gid = wgid / nig, fm = gid * WGM, gsz = (nM - fm) < WGM ? (nM - fm) : WGM;
        u.pm = fm + ((wgid % nig) % gsz); u.pn = (wgid % nig) / gsz; return true;
    }
};
template <class Epi, class Sched, bool ALIGN_EPI = false, bool SP2 = false>
__device__ __forceinline__ void gemm_phase(PG8_LAS unsigned char* lds, const Gemm g, const Sched& S, const Epi& E) {
    const int tid = threadIdx.x, wid = __builtin_amdgcn_readfirstlane(tid >> 6), lane = tid & 63, wr = wid >> 2, wc = wid & 3, fr = lane & 15, fq = lane >> 4;
    const int K = g.K;
    unsigned voffA[2], voffB[2];
#pragma unroll
    for (int i = 0; i < 2; ++i) { int R, C; stage_rc(tid * 16 + i * 8192, R, C); const int Rb = Epi::PERM ? ((R & ~31) + perm32(R & 31)) : R;
        voffA[i] = (unsigned)(R * K + C) * 2u; voffB[i] = (unsigned)(Rb * K + C) * 2u; }
    const size_t kstep = (size_t)(BK * 2);
    const size_t hstep = (size_t)HALF * K * 2;
    const size_t tstep = 2 * hstep;
    const unsigned ldsw = (unsigned)wid * 1024u;
    const int aoff = lds_byte(wr * 64 + fr, fq * 8), boff = lds_byte(wc * 32 + fr, fq * 8);
#define PG8_SA(b, h) (((b) * 2 + (h)) * HTB)
#define PG8_SB(b, h) ((4 + (b) * 2 + (h)) * HTB)
#define PG8_STAGE(bufoff, gbase, voff) do { _Pragma("unroll") for (int _i = 0; _i < 2; ++_i) \
        __builtin_amdgcn_global_load_lds((const unsigned*)((const char*)(gbase) + (voff)[_i]), (PG8_LAS unsigned*)(lds + (bufoff) + ldsw + _i * 8192), 16, 0, 0); } while (0)
#define PG8_LDA(dst, b, h) do { _Pragma("unroll") for (int m = 0; m < 4; ++m) _Pragma("unroll") for (int k = 0; k < 2; ++k) dst[m][k] = *(const PG8_LAS bf16x8*)(lds + PG8_SA(b, h) + aoff + m * 2048 + k * 1024); } while (0)
#define PG8_LDB(dst, b, h) do { _Pragma("unroll") for (int n = 0; n < 2; ++n) _Pragma("unroll") for (int k = 0; k < 2; ++k) dst[n][k] = *(const PG8_LAS bf16x8*)(lds + PG8_SB(b, h) + boff + n * 2048 + k * 1024); } while (0)
#define PG8_MMA(ai, bj, At, Bt) do { __builtin_amdgcn_s_setprio(1); _Pragma("unroll") for (int m = 0; m < 4; ++m) _Pragma("unroll") for (int n = 0; n < 2; ++n) _Pragma("unroll") for (int k = 0; k < 2; ++k) \
        acc[ai][bj][m][n] = __builtin_amdgcn_mfma_f32_16x16x32_bf16(Bt[n][k], At[m][k], acc[ai][bj][m][n], 0, 0, 0); __builtin_amdgcn_s_setprio(0); } while (0)
#define PG8_WAIT_V(n) asm volatile("s_waitcnt vmcnt(" #n ")" ::: "memory")
#define PG8_WAIT_L(n) asm volatile("s_waitcnt lgkmcnt(" #n ")" ::: "memory")
#define PG8_BAR __builtin_amdgcn_s_barrier()
#define PG8_SCHED __builtin_amdgcn_sched_barrier(0)
    Unit cur, nxt; int ui = 0;
    if (!S.next(0, cur)) return;
    f32x4 acc[2][2][4][2];
#pragma unroll
    for (int a = 0; a < 2; ++a)
#pragma unroll
        for (int b = 0; b < 2; ++b)
#pragma unroll
            for (int m = 0; m < 4; ++m)
#pragma unroll
                for (int n = 0; n < 2; ++n) acc[a][b][m][n] = (f32x4){0.f, 0.f, 0.f, 0.f};
    bf16x8 At[4][2], B0[2][2], B1[2][2];
    const char* cA = (const char*)(cur.src ? g.A1 : g.A0) + (size_t)cur.pm * tstep; const char* cB = (const char*)(cur.src ? g.B1 : g.B0) + (size_t)cur.pn * tstep;
    S.a_ready(cur);
    if constexpr (SP2) {
        PG8_STAGE(PG8_SB(0, 0), cB, voffB); PG8_STAGE(PG8_SB(0, 1), cB + hstep, voffB); PG8_STAGE(PG8_SA(0, 0), cA, voffA); PG8_STAGE(PG8_SA(0, 1), cA + hstep, voffA);
        if (wr == 1) PG8_BAR;
        PG8_WAIT_V(2); PG8_BAR;
        PG8_STAGE(PG8_SB(1, 0), cB + kstep, voffB); PG8_STAGE(PG8_SA(1, 0), cA + kstep, voffA); PG8_STAGE(PG8_SB(1, 1), cB + hstep + kstep, voffB);
        PG8_WAIT_V(6); PG8_BAR;
    } else {
        PG8_STAGE(PG8_SB(0, 0), cB, voffB); PG8_STAGE(PG8_SA(0, 0), cA, voffA); PG8_STAGE(PG8_SB(0, 1), cB + hstep, voffB); PG8_STAGE(PG8_SA(0, 1), cA + hstep, voffA);
        if (wr == 1) PG8_BAR;
        PG8_WAIT_V(4); PG8_BAR;
        PG8_STAGE(PG8_SB(1, 0), cB + kstep, voffB); PG8_STAGE(PG8_SA(1, 0), cA + kstep, voffA); PG8_STAGE(PG8_SB(1, 1), cB + hstep + kstep, voffB);
        PG8_WAIT_V(6); PG8_BAR;
    }
    for (;;) {
        const bool has_next = S.next(ui + 1, nxt);
        const char* nA = has_next ? (const char*)(nxt.src ? g.A1 : g.A0) + (size_t)nxt.pm * tstep : cA; const char* nB = has_next ? (const char*)(nxt.src ? g.B1 : g.B0) + (size_t)nxt.pn * tstep : cB;
        const int nt = cur.nt;
        for (int t = 0; t < nt; t += 2) {
            const bool last = (t == nt - 2);
            const char* a1 = cA + (size_t)(t + 1) * kstep;
            const char* a2 = last ? nA : cA + (size_t)(t + 2) * kstep; const char* b2 = last ? nB : cB + (size_t)(t + 2) * kstep;
            const char* a3 = a2 + kstep; const char* b3 = b2 + kstep;
            if (last && has_next) S.a_ready(nxt);
            if constexpr (SP2) {
            PG8_LDB(B0, 0, 0); PG8_LDB(B1, 0, 1); PG8_SCHED; PG8_LDA(At, 0, 0); PG8_STAGE(PG8_SA(1, 1), a1 + hstep, voffA);
            PG8_WAIT_V(8); PG8_WAIT_L(0); PG8_BAR; PG8_MMA(0, 0, At, B0); PG8_MMA(0, 1, At, B1); PG8_BAR; PG8_SCHED;
            PG8_LDA(At, 0, 1); PG8_STAGE(PG8_SB(0, 0), b2, voffB); PG8_STAGE(PG8_SB(0, 1), b2 + hstep, voffB); PG8_STAGE(PG8_SA(0, 0), a2, voffA);
            PG8_WAIT_V(8); PG8_WAIT_L(0); PG8_BAR; PG8_MMA(1, 0, At, B0); PG8_MMA(1, 1, At, B1); PG8_BAR; PG8_SCHED;
            PG8_LDB(B0, 1, 0); PG8_LDB(B1, 1, 1); PG8_SCHED; PG8_LDA(At, 1, 0); PG8_STAGE(PG8_SA(0, 1), a2 + hstep, voffA);
            PG8_WAIT_V(8); PG8_WAIT_L(0); PG8_BAR; PG8_MMA(0, 0, At, B0); PG8_MMA(0, 1, At, B1); PG8_BAR; PG8_SCHED;
            PG8_LDA(At, 1, 1); PG8_STAGE(PG8_SB(1, 0), b3, voffB); PG8_STAGE(PG8_SB(1, 1), b3 + hstep, voffB); PG8_STAGE(PG8_SA(1, 0), a3, voffA);
            PG8_WAIT_V(8); PG8_WAIT_L(0); PG8_BAR; PG8_MMA(1, 0, At, B0); PG8_MMA(1, 1, At, B1); PG8_BAR; PG8_SCHED;
            } else {
            PG8_LDB(B0, 0, 0); PG8_SCHED; PG8_LDA(At, 0, 0); PG8_STAGE(PG8_SA(1, 1), a1 + hstep, voffA);
            PG8_WAIT_L(8); PG8_BAR; PG8_WAIT_L(0); PG8_MMA(0, 0, At, B0); PG8_BAR; PG8_SCHED;
            PG8_LDB(B1, 0, 1); PG8_STAGE(PG8_SB(0, 0), b2, voffB);
            PG8_BAR; PG8_WAIT_L(0); PG8_MMA(0, 1, At, B1); PG8_BAR;
            PG8_LDA(At, 0, 1); PG8_STAGE(PG8_SA(0, 0), a2, voffA);
            PG8_BAR; PG8_WAIT_L(0); PG8_MMA(1, 0, At, B0); PG8_BAR; PG8_SCHED;
            PG8_STAGE(PG8_SB(0, 1), b2 + hstep, voffB);
            PG8_WAIT_V(6); PG8_BAR; PG8_MMA(1, 1, At, B1); PG8_BAR;
            PG8_LDB(B0, 1, 0); PG8_SCHED; PG8_LDA(At, 1, 0); PG8_STAGE(PG8_SA(0, 1), a2 + hstep, voffA);
            PG8_WAIT_L(8); PG8_BAR; PG8_WAIT_L(0); PG8_MMA(0, 0, At, B0); PG8_BAR; PG8_SCHED;
            PG8_LDB(B1, 1, 1); PG8_STAGE(PG8_SB(1, 0), b3, voffB);
            PG8_BAR; PG8_WAIT_L(0); PG8_MMA(0, 1, At, B1); PG8_BAR;
            PG8_LDA(At, 1, 1); PG8_STAGE(PG8_SA(1, 0), a3, voffA);
            PG8_BAR; PG8_WAIT_L(0); PG8_MMA(1, 0, At, B0); PG8_BAR; PG8_SCHED;
            PG8_STAGE(PG8_SB(1, 1), b3 + hstep, voffB);
            PG8_WAIT_V(6); PG8_BAR; PG8_MMA(1, 1, At, B1); PG8_BAR;
            }
        }
        if constexpr (ALIGN_EPI) { if (wr == 0) PG8_BAR; }
        if constexpr (!Epi::AFTER_DRAIN) { int fr_ = fr, fq_ = fq; asm volatile("" : "+v"(fr_), "+v"(fq_));
            E(acc, cur, wr, wc, fr_, fq_); S.done(cur); }
        if (!has_next) break;
#pragma unroll
        for (int a = 0; a < 2; ++a)
#pragma unroll
            for (int b = 0; b < 2; ++b)
#pragma unroll
                for (int m = 0; m < 4; ++m)
#pragma unroll
                    for (int n = 0; n < 2; ++n) acc[a][b][m][n] = (f32x4){0.f, 0.f, 0.f, 0.f};
        cur = nxt; cA = nA; cB = nB; ++ui;
        if constexpr (ALIGN_EPI) { if (wr == 1) PG8_BAR; }
    }
    PG8_WAIT_V(0);
    if constexpr (!ALIGN_EPI) { if (wr == 0) PG8_BAR; }
    PG8_BAR;
    if constexpr (Epi::AFTER_DRAIN) { E.fused(acc, cur, wr, wc, fr, fq, lds, wid, lane); S.done(cur); }
#undef PG8_SA
#undef PG8_SB
#undef PG8_STAGE
#undef PG8_LDA
#undef PG8_LDB
#undef PG8_MMA
#undef PG8_WAIT_V
#undef PG8_WAIT_L
#undef PG8_BAR
#undef PG8_SCHED
}
}
using pg8::Unit;

#define EPI_ROWS_BEGIN \
    _Pragma("unroll") for (int ai = 0; ai < 2; ++ai) _Pragma("unroll") for (int m = 0; m < 4; ++m) { const int row = u.pm * 256 + ai * 128 + wr * 64 + m * 16 + fr;
#define EPI_COLS_BEGIN \
    _Pragma("unroll") for (int bj = 0; bj < 2; ++bj) { const int c8 = u.pn * 256 + bj * 128 + wc * 32 + fq * 8; float v[8]; \
        v[0] = acc[ai][bj][m][0][0]; v[1] = acc[ai][bj][m][0][1]; v[2] = acc[ai][bj][m][0][2]; v[3] = acc[ai][bj][m][0][3]; \
        v[4] = acc[ai][bj][m][1][0]; v[5] = acc[ai][bj][m][1][1]; v[6] = acc[ai][bj][m][1][2]; v[7] = acc[ai][bj][m][1][3];
#define EPI_END } }

__device__ __forceinline__ void st8f(float* p, const float* v) { *(f32x4*)p = (f32x4){v[0], v[1], v[2], v[3]}; *(f32x4*)(p + 4) = (f32x4){v[4], v[5], v[6], v[7]}; }
__device__ __forceinline__ void ld8f(const float* p, float* v) { const f32x4 a = *(const f32x4*)p, b = *(const f32x4*)(p + 4); v[0] = a[0]; v[1] = a[1]; v[2] = a[2]; v[3] = a[3]; v[4] = b[0]; v[5] = b[1]; v[6] = b[2]; v[7] = b[3]; }
template <int XM> __device__ __forceinline__ void rope8(float* v, bool active, bool first, const f32x2* cs) {
    float pr[8];
#pragma unroll
    for (int j = 0; j < 8; ++j) pr[j] = __shfl_xor(v[j], XM);
    if (active) {
#pragma unroll
        for (int j = 0; j < 8; ++j) { const f32x2 c = cs[j]; v[j] = first ? v[j] * c.x - pr[j] * c.y : v[j] * c.x + pr[j] * c.y; }
    }
}

struct Epi1 {
    static constexpr bool PERM = true, AFTER_DRAIN = false;
    unsigned char* ws; float* out; const float *gate_b, *gq, *gkv;
    __device__ __forceinline__ void operator()(const f32x4 (&acc)[2][2][4][2], const Unit& u, int wr, int wc, int fr, int fq) const {
        const int pn = u.pn;
        bf16_t* const QA = (bf16_t*)(ws + WS_QA); bf16_t* const KA = (bf16_t*)(ws + WS_KA); bf16_t* const VA = (bf16_t*)(ws + WS_VA); bf16_t* const SZA = (bf16_t*)(ws + WS_SZA); bf16_t* const SZB = (bf16_t*)(ws + WS_SZB);
        bf16_t* const G = (bf16_t*)(out + O_Y); bf16_t* const CQ = (bf16_t*)(ws + WS_CQ); bf16_t* const CALL = (bf16_t*)(ws + WS_CALL); bf16_t* const KRB = (bf16_t*)(ws + WS_KR);
        float* const SSQ = (float*)(ws + WS_SSQ); float* const SSKV = (float*)(ws + WS_SSKV); const f32x2* const cs_da = (const f32x2*)(ws + WS_ROPE_DA); const f32x2* const cs_ml = (const f32x2*)(ws + WS_ROPE_ML);
        if (pn < 2) {
            EPI_ROWS_BEGIN const int pos = tok_pos(row);
            EPI_COLS_BEGIN
                if ((wc & 1) == 0) rope8<16>(v, fq < 2, fq == 0, cs_da + pos * 8);
#pragma unroll
                for (int j = 0; j < 8; ++j) v[j] *= C2A;
                *(u32x4*)(QA + (size_t)row * 512 + c8) = pack8(v);
            EPI_END
        } else if (pn < 4) {
            EPI_ROWS_BEGIN const int pos = tok_pos(row); const int kr = tok_krow(row);
                float* orow = row < MP ? out + O_KP + (size_t)row * 512 : out + O_KS + (size_t)(row - MP) * 512;
            EPI_COLS_BEGIN const int c = c8 - 512;
                if ((wc & 1) == 0) rope8<16>(v, fq < 2, fq == 0, cs_da + pos * 8);
                st8f(orow + c, v);
                *(u32x4*)(KA + (size_t)kr * 512 + c) = pack8(v);
            EPI_END
        } else if (pn < 6) {
            EPI_ROWS_BEGIN const int kr = tok_krow(row);
                float* orow = row < MP ? out + O_VP + (size_t)row * 512 : out + O_VS + (size_t)(row - MP) * 512;
            EPI_COLS_BEGIN const int c = c8 - 1024;
                st8f(orow + c, v);
                *(u32x4*)(VA + (size_t)kr * 512 + c) = pack8(v);
            EPI_END
        } else if (pn < 10) {
            bf16_t* dst = pn < 8 ? SZA : SZB; const int cb = pn < 8 ? 1536 : 2048;
            EPI_ROWS_BEGIN
            EPI_COLS_BEGIN const int c = c8 - cb;
#pragma unroll
                for (int j = 0; j < 8; ++j) v[j] = siluf_(v[j]);
                *(u32x4*)(dst + (size_t)row * 512 + c) = pack8(v);
            EPI_END
        } else if (pn < 18) {
            EPI_ROWS_BEGIN
            EPI_COLS_BEGIN const int c = c8 - 2560; float b[8]; ld8f(gate_b + c, b);
#pragma unroll
                for (int j = 0; j < 8; ++j) v[j] = sigmoidf_(v[j] + b[j]);
                *(u32x4*)(G + (size_t)row * 2048 + c) = pack8(v);
            EPI_END
        } else if (pn == 20) {
            EPI_ROWS_BEGIN const int kr = tok_krow(row);
                float* orow = row < MP ? out + O_LP + (size_t)row * 256 : out + O_LS + (size_t)(row - MP) * 256;
            EPI_COLS_BEGIN const int c = c8 - 5120; float g[8]; ld8f(gkv + c, g); float ss = 0.f;
#pragma unroll
                for (int j = 0; j < 8; ++j) { ss += v[j] * v[j]; v[j] *= g[j]; }
                ss += __shfl_xor(ss, 16); ss += __shfl_xor(ss, 32);
                if (fq == 0) SSKV[(size_t)row * 8 + bj * 4 + wc] = ss;
                st8f(orow + c, v);
                *(u32x4*)(CALL + (size_t)kr * 384 + c) = pack8(v);
            EPI_END
        } else {
            EPI_ROWS_BEGIN const int pos = tok_pos(row); const int kr = tok_krow(row);
            EPI_COLS_BEGIN
                if (pn == 18 || bj == 0) {
                    const int c = c8 - 4608; float g[8]; ld8f(gq + c, g); float ss = 0.f;
#pragma unroll
                    for (int j = 0; j < 8; ++j) { ss += v[j] * v[j]; v[j] *= g[j]; }
                    ss += __shfl_xor(ss, 16); ss += __shfl_xor(ss, 32);
                    if (fq == 0) SSQ[(size_t)row * 16 + (pn - 18) * 8 + bj * 4 + wc] = ss;
                    *(u32x4*)(CQ + (size_t)row * 384 + c) = pack8(v);
                } else if (wc == 0) {
                    const int c = fq * 8;
                    rope8<32>(v, true, fq < 2, cs_ml + pos * 16 + (fq & 1) * 8);
                    float* orow = row < MP ? out + O_RP + (size_t)row * 32 : out + O_RS + (size_t)(row - MP) * 32;
                    st8f(orow + c, v);
                    *(u32x4*)(KRB + (size_t)kr * 32 + c) = pack8(v);
                }
            EPI_END
        }
    }
};
struct Epi2a {
    static constexpr bool PERM = true, AFTER_DRAIN = false;
    bf16_t* QM; const float* SSQ; const f32x2* cs_ml;
    __device__ __forceinline__ void operator()(const f32x4 (&acc)[2][2][4][2], const Unit& u, int wr, int wc, int fr, int fq) const {
        EPI_ROWS_BEGIN const int pos = tok_pos(row);
            float s = 0.f; { const f32x4* p = (const f32x4*)(SSQ + (size_t)row * 16); const f32x4 a = p[0], b = p[1], c = p[2]; s = (a[0] + a[1] + a[2] + a[3]) + (b[0] + b[1] + b[2] + b[3]) + (c[0] + c[1] + c[2] + c[3]); }
            const float sc = rsqrtf(s * (1.0f / 384.0f) + RMS_EPS) * C2M;
        EPI_COLS_BEGIN
            const int g32 = u.pn * 8 + bj * 4 + wc;
#pragma unroll
            for (int j = 0; j < 8; ++j) v[j] *= sc;
            if (g32 % 3 == 2) rope8<32>(v, true, fq < 2, cs_ml + pos * 16 + (fq & 1) * 8);
            *(u32x4*)(QM + (size_t)row * 768 + c8) = pack8(v);
        EPI_END
    }
};
struct Epi2b {
    static constexpr bool PERM = true, AFTER_DRAIN = false;
    bf16_t *KN, *VM; const float* SSKV;
    __device__ __forceinline__ void operator()(const f32x4 (&acc)[2][2][4][2], const Unit& u, int wr, int wc, int fr, int fq) const {
        EPI_ROWS_BEGIN
            int trow = row; bool isnew = true;
            if (row >= MP) { const int s = row - MP, b = s / TS, t = s - b * TS; isnew = t >= PAST; trow = MP + b * 64 + (t - PAST); }
            float sc = 1.0f;
            if (isnew) { const f32x4* p = (const f32x4*)(SSKV + (size_t)trow * 8); const f32x4 a = p[0], b = p[1]; sc = rsqrtf(((a[0] + a[1] + a[2] + a[3]) + (b[0] + b[1] + b[2] + b[3])) * (1.0f / 256.0f) + RMS_EPS); }
        EPI_COLS_BEGIN
#pragma unroll
            for (int j = 0; j < 8; ++j) v[j] *= sc;
            if (u.pn < 2) *(u32x4*)(KN + (size_t)row * 512 + c8) = pack8(v);
            else *(u32x4*)(VM + (size_t)row * 512 + (c8 - 512)) = pack8(v);
        EPI_END
    }
};
struct Epi3a {
    static constexpr bool PERM = true, AFTER_DRAIN = false;
    float* T; const bf16_t* G;
    __device__ __forceinline__ void operator()(const f32x4 (&acc)[2][2][4][2], const Unit& u, int wr, int wc, int fr, int fq) const {
        EPI_ROWS_BEGIN
        EPI_COLS_BEGIN float g[8]; unpack8(*(const u32x4*)(G + (size_t)row * 2048 + c8), g);
#pragma unroll
            for (int j = 0; j < 8; ++j) v[j] *= g[j];
            st8f(T + (size_t)row * 1024 + c8, v);
        EPI_END
    }
};
struct Epi3b {
    static constexpr bool PERM = true, AFTER_DRAIN = false;
    const float* T; const bf16_t* G; bf16_t* MM;
    __device__ __forceinline__ void operator()(const f32x4 (&acc)[2][2][4][2], const Unit& u, int wr, int wc, int fr, int fq) const {
        EPI_ROWS_BEGIN
        EPI_COLS_BEGIN float g[8], t[8]; unpack8(*(const u32x4*)(G + (size_t)row * 2048 + 1024 + c8), g); ld8f(T + (size_t)row * 1024 + c8, t);
#pragma unroll
            for (int j = 0; j < 8; ++j) v[j] = t[j] + v[j] * g[j];
            *(u32x4*)(MM + (size_t)row * 1024 + c8) = pack8(v);
        EPI_END
    }
};
struct Epi4 {
    static constexpr bool PERM = true, AFTER_DRAIN = false;
    const float *xp, *xs; float* Y; float* SSY;
    __device__ __forceinline__ void operator()(const f32x4 (&acc)[2][2][4][2], const Unit& u, int wr, int wc, int fr, int fq) const {
        EPI_ROWS_BEGIN const float* xr = row < MP ? xp + (size_t)row * 1024 : xs + (size_t)(row - MP) * 1024;
        EPI_COLS_BEGIN float x[8]; ld8f(xr + c8, x); float ss = 0.f;
#pragma unroll
            for (int j = 0; j < 8; ++j) { v[j] += x[j]; ss += v[j] * v[j]; }
            ss += __shfl_xor(ss, 16); ss += __shfl_xor(ss, 32);
            if (fq == 0) SSY[(size_t)row * 32 + u.pn * 8 + bj * 4 + wc] = ss;
            st8f(Y + (size_t)row * 1024 + c8, v);
        EPI_END
    }
};

struct SchedGrid {
    pg8::StaticOrder so; int nt;
    __device__ __forceinline__ bool next(int i, Unit& u) const { if (!so.next(i, u)) return false; u.src = 0; u.nt = nt; return true; }
    __device__ __forceinline__ void a_ready(const Unit&) const {}
    __device__ __forceinline__ void done(const Unit&) const {}
};
struct SchedP2 {
    int G, c;
    static constexpr int NA = (MT / 256) * 3, NBU = (KR / 256) * 4;
    __device__ __forceinline__ bool next(int i, Unit& u) const {
        const int j = i * G + c; if (j >= NA + NBU) return false;
        if (j < NA) { u.pm = j / 3; u.pn = j % 3; u.src = 0; u.nt = 6; } else { const int k = j - NA; u.pm = k >> 2; u.pn = k & 3; u.src = 1; u.nt = 4; }
        return true; }
    __device__ __forceinline__ void a_ready(const Unit&) const {}
    __device__ __forceinline__ void done(const Unit&) const {}
};
struct SchedTwoPass {
    pg8::StaticOrder so; int nt;
    __device__ __forceinline__ bool next(int i, Unit& u) const { if (!so.next(i >> 1, u)) return false; u.src = i & 1; u.nt = nt; return true; }
    __device__ __forceinline__ void a_ready(const Unit&) const {}
    __device__ __forceinline__ void done(const Unit&) const {}
};
struct Epi2 {
    static constexpr bool PERM = true, AFTER_DRAIN = false;
    Epi2a ea; Epi2b eb;
    __device__ __forceinline__ void operator()(const f32x4 (&acc)[2][2][4][2], const Unit& u, int wr, int wc, int fr, int fq) const { if (u.src == 0) ea(acc, u, wr, wc, fr, fq); else eb(acc, u, wr, wc, fr, fq); }
};
struct Epi3 {
    static constexpr bool PERM = true, AFTER_DRAIN = false;
    Epi3a ea; Epi3b eb;
    __device__ __forceinline__ void operator()(const f32x4 (&acc)[2][2][4][2], const Unit& u, int wr, int wc, int fr, int fq) const {
        if (u.src == 0) { ea(acc, u, wr, wc, fr, fq); asm volatile("s_waitcnt vmcnt(0)" ::: "memory"); } else eb(acc, u, wr, wc, fr, fq); }
};

__device__ __forceinline__ int win_dst(int n) {
    if (n < 2048) return n;
    if (n < 2432) return n - 2048 + 4608;
    if (n < 2688) return n - 2432 + 5120;
    if (n < 2720) return n - 2688 + 4992;
    if (n < 3232) return n - 2720 + 2048;
    return n - 3232 + 2560;
}
__device__ __forceinline__ void transpose_item(const float* __restrict__ W, int K, int N, bf16_t* WT, int k0, int n0, int drow0, LAS float* scr, int lane) {
#pragma unroll 8
    for (int i = 0; i < 32; ++i) { const int kk = 2 * i + (lane >> 5); scr[kk * 33 + (lane & 31)] = W[(size_t)(k0 + kk) * N + n0 + (lane & 31)]; }
    asm volatile("s_waitcnt lgkmcnt(0)" ::: "memory");
    const int c = lane & 7;
#pragma unroll
    for (int j = 0; j < 4; ++j) { const int n = (lane >> 3) + 8 * j; const LAS float* s = scr + (8 * c) * 33 + n;
        u32x4 o; o.x = pk2(s[0 * 33], s[1 * 33]); o.y = pk2(s[2 * 33], s[3 * 33]); o.z = pk2(s[4 * 33], s[5 * 33]); o.w = pk2(s[6 * 33], s[7 * 33]);
        *(u32x4*)(WT + (size_t)(drow0 + n) * K + k0 + 8 * c) = o; }
    asm volatile("s_waitcnt lgkmcnt(0)" ::: "memory");
}
__device__ __forceinline__ void sincos_acc(float angf, float& c, float& s) {
    const double x = (double)angf; const double n = __builtin_rint(x * 0.63661977236758134308);
    const double r = __builtin_fma(-n, 1.5707963267948966192, x) - n * 6.123233995736766e-17; const double r2 = r * r;
    double sp = -1.0 / 1307674368000.0; sp = sp * r2 + 1.0 / 6227020800.0; sp = sp * r2 - 1.0 / 39916800.0; sp = sp * r2 + 1.0 / 362880.0; sp = sp * r2 - 1.0 / 5040.0; sp = sp * r2 + 1.0 / 120.0; sp = sp * r2 - 1.0 / 6.0; sp = sp * r2 + 1.0; sp *= r;
    double cp = 1.0 / 20922789888000.0; cp = cp * r2 - 1.0 / 87178291200.0; cp = cp * r2 + 1.0 / 479001600.0; cp = cp * r2 - 1.0 / 3628800.0; cp = cp * r2 + 1.0 / 40320.0; cp = cp * r2 - 1.0 / 720.0; cp = cp * r2 + 1.0 / 24.0; cp = cp * r2 - 0.5; cp = cp * r2 + 1.0;
    const int q = ((int)n) & 3;
    const double ss = (q == 0) ? sp : (q == 1) ? cp : (q == 2) ? -sp : -cp;
    const double cc = (q == 0) ? cp : (q == 1) ? -sp : (q == 2) ? -cp : sp;
    c = (float)cc; s = (float)ss;
}
__device__ __forceinline__ void p0_prologue(const Args& a, LAS unsigned char* lds) {
    const int tid = threadIdx.x, lane = tid & 63, wave = tid >> 6;
    const int G = gridDim.x, gw = blockIdx.x * NWAVES + wave, NGW = G * NWAVES, gt = blockIdx.x * NTHREADS + tid, NGT = G * NTHREADS;
    unsigned char* ws = a.ws;
    LAS float* scr = (LAS float*)(lds + wave * 8704);
    if (blockIdx.x == 0 && wave == 0) {
        if (lane < 16) ((unsigned*)(ws + WS_CTL))[lane] = 0u;
        const float* L = a.in[9];
        const float sa = wave_sum(L[lane] * L[64 + lane]), sb = wave_sum(L[128 + lane] * L[192 + lane]);
        if (lane == 0) ((float*)(ws + WS_LAM))[0] = expf(sa) - expf(sb) + LAM_INIT;
    }
    for (int i = gt; i < 4096 * 8; i += NGT) { const int pos = i >> 3, j = i & 7; float c, s; sincos_acc((float)pos * c_inv_da[j], c, s); ((f32x2*)(ws + WS_ROPE_DA))[i] = (f32x2){c, s}; }
    for (int i = gt; i < 4096 * 16; i += NGT) { const int pos = i >> 4, j = i & 15; float c, s; sincos_acc((float)pos * c_inv_ml[j], c, s); ((f32x2*)(ws + WS_ROPE_ML))[i] = (f32x2){c, s}; }
    constexpr int I_IN = 16 * 165, I_UQ = 6 * 24, I_UK = 4 * 16, I_UV = 4 * 16, I_A = 8 * 32, I_B = 8 * 32, I_O = 16 * 32;
    constexpr int NITEMS = I_IN + I_UQ + I_UK + I_UV + I_A + I_B + I_O;
    for (int it = gw; it < NITEMS; it += NGW) {
        int r = it;
        if (r < I_IN) { const int kb = r / 165, nb = r % 165; transpose_item(a.in[7], 1024, 5280, (bf16_t*)(ws + WS_WIN), kb * 64, nb * 32, win_dst(nb * 32), scr, lane); continue; } r -= I_IN;
        if (r < I_UQ) { const int kb = r / 24, nb = r % 24; transpose_item(a.in[13], 384, 768, (bf16_t*)(ws + WS_WUQ), kb * 64, nb * 32, nb * 32, scr, lane); continue; } r -= I_UQ;
        if (r < I_UK) { const int kb = r / 16, nb = r % 16; transpose_item(a.in[14], 384, 512, (bf16_t*)(ws + WS_WUKV), kb * 64, nb * 32, nb * 32, scr, lane); continue; } r -= I_UK;
        if (r < I_UV) { const int kb = r / 16, nb = r % 16; transpose_item(a.in[15], 384, 512, (bf16_t*)(ws + WS_WUKV), kb * 64, nb * 32, 512 + nb * 32, scr, lane); continue; } r -= I_UV;
        if (r < I_A) { const int kb = r / 32, nb = r % 32; transpose_item(a.in[16], 512, 1024, (bf16_t*)(ws + WS_WA), kb * 64, nb * 32, nb * 32, scr, lane); continue; } r -= I_A;
        if (r < I_B) { const int kb = r / 32, nb = r % 32; transpose_item(a.in[17], 512, 1024, (bf16_t*)(ws + WS_WB), kb * 64, nb * 32, nb * 32, scr, lane); continue; } r -= I_B;
        { const int kb = r / 32, nb = r % 32; transpose_item(a.in[18], 1024, 1024, (bf16_t*)(ws + WS_WOUT), kb * 64, nb * 32, nb * 32, scr, lane); }
    }
    { u32x4* z = (u32x4*)((bf16_t*)(ws + WS_WIN) + (size_t)5024 * 1024); for (int i = gt; i < 96 * 1024 / 8; i += NGT) z[i] = (u32x4){0u, 0u, 0u, 0u}; }
    {
        const float* gp = a.in[6]; f32x4 g[4];
#pragma unroll
        for (int j = 0; j < 4; ++j) g[j] = ((const f32x4*)gp)[lane + 64 * j];
        for (int m = gw; m < MT; m += NGW) {
            const float* xr = m < MP ? a.in[0] + (size_t)m * 1024 : a.in[1] + (size_t)(m - MP) * 1024;
            f32x4 v[4]; float s = 0.f;
#pragma unroll
            for (int j = 0; j < 4; ++j) { v[j] = ((const f32x4*)xr)[lane + 64 * j]; s += (v[j][0] * v[j][0] + v[j][1] * v[j][1]) + (v[j][2] * v[j][2] + v[j][3] * v[j][3]); }
            const float rstd = rsqrtf(wave_sum(s) * (1.0f / 1024.0f) + RMS_EPS);
            u32x2* o = (u32x2*)((bf16_t*)(ws + WS_XN) + (size_t)m * 1024);
#pragma unroll
            for (int j = 0; j < 4; ++j) { u32x2 w; w.x = pk2(v[j][0] * rstd * g[j][0], v[j][1] * rstd * g[j][1]); w.y = pk2(v[j][2] * rstd * g[j][2], v[j][3] * rstd * g[j][3]); o[lane + 64 * j] = w; }
        }
    }
    for (int i = gt; i < DECB * PAST * 512 / 4; i += NGT) {
        const int e = i * 4, bt = e >> 9, c = e & 511, b = bt >> 10, t = bt & 1023; const size_t d = (size_t)(MP + b * TS + t) * 512 + c;
        const f32x4 k = ((const f32x4*)a.in[2])[i], v = ((const f32x4*)a.in[3])[i];
        *(u32x2*)((bf16_t*)(ws + WS_KA) + d) = (u32x2){pk2(k[0], k[1]), pk2(k[2], k[3])};
        *(u32x2*)((bf16_t*)(ws + WS_VA) + d) = (u32x2){pk2(v[0], v[1]), pk2(v[2], v[3])};
    }
    for (int i = gt; i < DECB * PAST * 256 / 4; i += NGT) {
        const int e = i * 4, bt = e >> 8, c = e & 255, b = bt >> 10, t = bt & 1023; const size_t d = (size_t)(MP + b * TS + t) * 384 + c;
        const f32x4 k = ((const f32x4*)a.in[4])[i];
        *(u32x2*)((bf16_t*)(ws + WS_CALL) + d) = (u32x2){pk2(k[0], k[1]), pk2(k[2], k[3])};
    }
    for (int i = gt; i < DECB * PAST * 32 / 4; i += NGT) {
        const int e = i * 4, bt = e >> 5, c = e & 31, b = bt >> 10, t = bt & 1023; const size_t d = (size_t)(MP + b * TS + t) * 32 + c;
        const f32x4 k = ((const f32x4*)a.in[5])[i];
        *(u32x2*)((bf16_t*)(ws + WS_KR) + d) = (u32x2){pk2(k[0], k[1]), pk2(k[2], k[3])};
    }
}

constexpr int A_SLOT = 16384;
constexpr int A_K = 0, A_V = 3 * A_SLOT, A_X = 0, A_WS = 6 * A_SLOT;
constexpr float A_THR = 8.0f;
#define MFMA32(a, b, c) __builtin_amdgcn_mfma_f32_32x32x16_bf16(a, b, c, 0, 0, 0)
#define SBAR() __builtin_amdgcn_sched_barrier(0)
#define PIN(x) asm volatile("" : "+v"(x))
typedef short v4i16_t __attribute__((ext_vector_type(4)));
__device__ __forceinline__ s16x4 vtr(const LAS unsigned char* p) { return __builtin_bit_cast(s16x4, __builtin_amdgcn_ds_read_tr16_b64_v4i16((LAS v4i16_t*)p)); }
__device__ __forceinline__ bf16x8 vfrag(const LAS unsigned char* p) { const s16x4 lo = vtr(p), hh = vtr(p + 512); return (bf16x8){lo[0], lo[1], lo[2], lo[3], hh[0], hh[1], hh[2], hh[3]}; }
__device__ __forceinline__ float max3f(float a, float b, float c) { return __builtin_fmaxf(__builtin_fmaxf(a, b), c); }

__device__ __forceinline__ void glds16(const void* g, unsigned lds_base) {
    unsigned sv; asm volatile("s_mov_b32 %0, m0\n\ts_mov_b32 m0, %2\n\ts_nop 0\n\tglobal_load_lds_dwordx4 %1, off\n\ts_mov_b32 m0, %0" : "=&s"(sv) : "v"(g), "s"(lds_base) : "memory"); }
#define ATT_WAIT_BAR() asm volatile("s_waitcnt vmcnt(0) lgkmcnt(0)\n\ts_barrier" ::: "memory")
__device__ __forceinline__ void att_wait_bar_n(int n) {
    if (n == 0) asm volatile("s_waitcnt vmcnt(0) lgkmcnt(0)\n\ts_barrier" ::: "memory");
    else if (n == 1) asm volatile("s_waitcnt vmcnt(1) lgkmcnt(0)\n\ts_barrier" ::: "memory");
    else if (n == 2) asm volatile("s_waitcnt vmcnt(2) lgkmcnt(0)\n\ts_barrier" ::: "memory");
    else if (n == 3) asm volatile("s_waitcnt vmcnt(3) lgkmcnt(0)\n\ts_barrier" ::: "memory");
    else asm volatile("s_waitcnt vmcnt(4) lgkmcnt(0)\n\ts_barrier" ::: "memory");
}
struct AUnit { int qrow0, kbase, nt, nrow, h; };

template <int ND0, int NDB, bool GQK, bool GPV>
__device__ __forceinline__ void attn_step(bf16x8 (&kf)[2 * ND0], const bf16x8 (&qr)[ND0], f32x16& C0, f32x16& C1, const f32x16& P0, const f32x16& P1, f32x16 (&o)[NDB],
                                          float& mrow, float& lrow, bool& resc, LAS float* wsf, const LAS unsigned char* kn, const LAS unsigned char* vb, int r32, int hi, bool upd = true) {
    constexpr int NQ = GQK ? 2 * ND0 : 0, NP = GPV ? 4 * NDB : 0, NG = NQ + NP, LA = 3, EPG = GPV ? 32 / (4 * NDB) : 32;
    bf16x8 vf[4]; u32x4 pw[4]; float sacc = 0.f;
    resc = false;
    if constexpr (GPV && !GQK) {
#pragma unroll
        for (int u = 0; u < 8; ++u) { const f32x16& S = u < 4 ? P0 : P1; const int b = (u & 3) * 4;
            sacc += (S[b] + S[b + 1]) + (S[b + 2] + S[b + 3]); pw[u >> 1][(u & 1) * 2] = pk2(S[b], S[b + 1]); pw[u >> 1][(u & 1) * 2 + 1] = pk2(S[b + 2], S[b + 3]); }
    }
#pragma unroll
    for (int j = 0; j < NP; ++j) if (NQ + j - LA < 0) vf[j & 3] = vfrag(vb + (j % NDB) * 4096 + (j / NDB) * 1024);
    SBAR();
#pragma unroll
    for (int g = 0; g < NG; ++g) {
#pragma unroll
        for (int j = 0; j < NP; ++j) if (NQ + j - LA == g) vf[j & 3] = vfrag(vb + (j % NDB) * 4096 + (j / NDB) * 1024);
        if (g < NQ) {
            if (g < 2) { if (g & 1) C1 = MFMA32(kf[g], qr[g >> 1], f32x16{}); else C0 = MFMA32(kf[g], qr[g >> 1], f32x16{}); }
            else { if (g & 1) C1 = MFMA32(kf[g], qr[g >> 1], C1); else C0 = MFMA32(kf[g], qr[g >> 1], C0); }
            if (GPV && g < 8) { const int u = g; const f32x16& S = u < 4 ? P0 : P1; const int b = (u & 3) * 4;
                sacc += S[b]; sacc += S[b + 1]; sacc += S[b + 2]; sacc += S[b + 3]; PIN(sacc);
                pw[u >> 1][(u & 1) * 2] = pk2(S[b], S[b + 1]); pw[u >> 1][(u & 1) * 2 + 1] = pk2(S[b + 2], S[b + 3]); PIN(pw[u >> 1]); }
        } else {
            const int j = g - NQ, ks = j / NDB, d = j % NDB;
            if (GQK) {
                if (ND0 == 4) { if (j >= 4 && j < 12) kf[j - 4] = *(const LAS bf16x8*)(kn + ((j - 4) >> 1) * 2048 + ((j - 4) & 1) * 512); }
                else { if (j >= 1 && j < 7) { const int q = j - 1; kf[2 * q] = *(const LAS bf16x8*)(kn + q * 2048); kf[2 * q + 1] = *(const LAS bf16x8*)(kn + q * 2048 + 512); } }
            }
            o[d] = MFMA32(__builtin_bit_cast(bf16x8, pw[ks]), vf[j & 3], o[d]);
            if (GQK) {
#pragma unroll
                for (int e = j * EPG; e < (j + 1) * EPG; ++e) { if (e < 16) C0[e] = __builtin_amdgcn_exp2f(C0[e] - mrow); else C1[e - 16] = __builtin_amdgcn_exp2f(C1[e - 16] - mrow); }
                if ((j * EPG) < 16) PIN(C0); else PIN(C1);
            }
        }
        SBAR();
        if (GQK && g == NQ - 1) {
            if (GPV) lrow += sacc;
            float a = max3f(C0[0], C0[1], C1[0]), b = max3f(C0[2], C0[3], C1[1]); a = max3f(a, C1[2], C1[3]);
#pragma unroll
            for (int r = 4; r < 16; r += 4) { a = max3f(a, C0[r], C0[r + 1]); b = max3f(b, C0[r + 2], C0[r + 3]); a = max3f(a, C1[r], C1[r + 1]); b = max3f(b, C1[r + 2], C1[r + 3]); }
            float rm = __builtin_fmaxf(a, b); rm = __builtin_fmaxf(rm, __shfl_xor(rm, 32));
            if (!GPV) mrow = rm;
            else if (upd && __builtin_expect(__any(rm > mrow + A_THR), 0)) {
                const float mn = __builtin_fmaxf(mrow, rm), f = __builtin_amdgcn_exp2f(mrow - mn); mrow = mn; lrow *= f;
                if (hi == 0) wsf[r32] = f;
                resc = true;
            }
            SBAR();
        }
    }
    if constexpr (GQK && !GPV) {
#pragma unroll
        for (int r = 0; r < 16; ++r) { C0[r] = __builtin_amdgcn_exp2f(C0[r] - mrow); C1[r] = __builtin_amdgcn_exp2f(C1[r] - mrow); }
#pragma unroll
        for (int i = 0; i < 2 * ND0; ++i) kf[i] = *(const LAS bf16x8*)(kn + (i >> 1) * 2048 + (i & 1) * 512);
    }
    if constexpr (GPV && !GQK) lrow += sacc;
}

template <bool DA>
__device__ __forceinline__ void attn_unit(LAS unsigned char* lds, const AUnit U, const Args& a) {
    constexpr int DQK = DA ? 64 : 96, DV = DA ? 128 : 64, ND0 = DQK / 16, NDB = DV / 32;
    const int tid = threadIdx.x, lane = tid & 63, r32 = lane & 31, hi = lane >> 5; const int wid = __builtin_amdgcn_readfirstlane(tid >> 6);
    unsigned char* ws = a.ws;
    const int wq = DA ? (wid & 3) : wid, comp = DA ? (wid >> 2) : 0;
    const int wrow = wq * 32; const bool active = wrow < U.nrow;
    const int myrow0 = U.qrow0 + wrow;
    const int my_nt = active ? (tok_pos(myrow0) >> 6) + 1 : 0;
    bf16x8 qr[ND0];
    {
        const bf16_t* Qb = DA ? (const bf16_t*)(ws + WS_QA) + (size_t)(myrow0 + r32) * 512 + U.h * 128 + comp * 64 : (const bf16_t*)(ws + WS_QM) + (size_t)(myrow0 + r32) * 768 + U.h * 96;
#pragma unroll
        for (int d0 = 0; d0 < ND0; ++d0) qr[d0] = active ? *(const bf16x8*)(Qb + d0 * 16 + hi * 8) : (bf16x8){0, 0, 0, 0, 0, 0, 0, 0};
    }
    const bf16_t *ksrc0, *ksrc1, *vsrc0, *vsrc1; size_t kst0, kst1;
    const int vrow = 16 * (wid & 3) + (lane >> 2), vsub = (lane & 3) * 8;
    if (DA) {
        ksrc0 = (const bf16_t*)(ws + WS_KA) + (size_t)(U.kbase + lane) * 512 + U.h * 128 + wid * 8; ksrc1 = ksrc0 + 64; kst0 = kst1 = 64 * 512;
        vsrc0 = (const bf16_t*)(ws + WS_VA) + (size_t)(U.kbase + vrow) * 512 + U.h * 128 + (wid >> 2) * 32 + vsub; vsrc1 = vsrc0 + 64;
    } else {
        ksrc0 = (const bf16_t*)(ws + WS_KN) + (size_t)(U.kbase + lane) * 512 + U.h * 64 + wid * 8; kst0 = 64 * 512;
        ksrc1 = (const bf16_t*)(ws + WS_KR) + (size_t)(U.kbase + lane) * 32 + (wid & 3) * 8; kst1 = 64 * 32;
        vsrc0 = (const bf16_t*)(ws + WS_VM) + (size_t)(U.kbase + vrow) * 512 + U.h * 64 + (wid >> 2) * 32 + vsub; vsrc1 = vsrc0;
    }
    LAS unsigned char* const kdst = lds + A_K + wid * 1024; LAS unsigned char* const vdst = lds + A_V + wid * 1024;
#define DMA16(g, l) glds16((g), (unsigned)__builtin_amdgcn_readfirstlane((int)(unsigned)(uintptr_t)(l)))
#define DMA_K(t, slot) do { DMA16(ksrc0 + (size_t)(t) * kst0, kdst + (slot) * A_SLOT); if (DA || wid < 4) DMA16(ksrc1 + (size_t)(t) * kst1, kdst + (slot) * A_SLOT + 8192); } while (0)
#define DMA_V(t, slot) do { DMA16(vsrc0 + (size_t)(t) * 64 * 512, vdst + (slot) * A_SLOT); if (DA) DMA16(vsrc1 + (size_t)(t) * 64 * 512, vdst + (slot) * A_SLOT + 8192); } while (0)
    LAS float* wsf = (LAS float*)(lds + A_WS) + wid * 64;
    const LAS unsigned char* const kp0 = lds + A_K + hi * 1024 + r32 * 16 + (DA ? comp * 8192 : 0);
    const LAS unsigned char* const vp0 = lds + A_V + ((lane >> 4) & 1) * 32 + (lane & 3) * 8 + (4 * hi + ((lane & 15) >> 2)) * 64;
    f32x16 o[NDB];
#pragma unroll
    for (int d = 0; d < NDB; ++d) o[d] = f32x16{};
    float mrow = 0.f, lrow = 0.f; bool resc = false;
    f32x16 pA0, pA1, pB0, pB1; bf16x8 kf[2 * ND0];
    pA0 = f32x16{}; pA1 = f32x16{}; pB0 = f32x16{}; pB1 = f32x16{};
    DMA_K(0, 0); DMA_K(1, 1); if (2 < U.nt) DMA_K(2, 2); DMA_V(0, 0);
#pragma unroll
    for (int d0 = 0; d0 < ND0; ++d0) PIN(qr[d0]);
    ATT_WAIT_BAR();
#pragma unroll
    for (int i = 0; i < 2 * ND0; ++i) kf[i] = *(const LAS bf16x8*)(kp0 + (i >> 1) * 2048 + (i & 1) * 512);
    ATT_WAIT_BAR();
    const int NKD = DA ? 2 : (wid < 4 ? 2 : 1), NVD = DA ? 2 : 1;
    int s0 = 0, s1 = 1, s2 = 2;
#define RESC() do { if (resc) { asm volatile("s_waitcnt lgkmcnt(0)" ::: "memory"); _Pragma("unroll") for (int r = 0; r < 16; ++r) { const float f_ = wsf[crow(r, hi)]; \
        _Pragma("unroll") for (int d = 0; d < NDB; ++d) o[d][r] *= f_; } asm volatile("s_waitcnt lgkmcnt(0)" ::: "memory"); } } while (0)
#define STEP_TOP(t) \
        int nd_ = 0; if ((t) + 3 < U.nt) { DMA_K((t) + 3, s0); nd_ += NKD; } if ((t) + 1 < U.nt) { DMA_V((t) + 1, s1); nd_ += NVD; } \
        const LAS unsigned char* kn_ = kp0 + s1 * A_SLOT; const LAS unsigned char* vb_ = vp0 + s2 * A_SLOT; resc = false;
#define STEP_END() do { att_wait_bar_n(nd_); { const int s_ = s0; s0 = s1; s1 = s2; s2 = s_; } } while (0)
#define STEP(CA, CB, PA, PB, t) do { STEP_TOP(t) \
        if ((t) <= my_nt) attn_step<ND0, NDB, true, true>(kf, qr, CA, CB, PA, PB, o, mrow, lrow, resc, wsf, kn_, vb_, r32, hi, (t) < my_nt); \
        STEP_END(); \
        RESC(); } while (0)
    { STEP_TOP(0) if (my_nt > 0) attn_step<ND0, NDB, true, false>(kf, qr, pA0, pA1, pB0, pB1, o, mrow, lrow, resc, wsf, kn_, vb_, r32, hi); STEP_END(); }
    for (int t = 1; t < U.nt; t += 2) {
        STEP(pB0, pB1, pA0, pA1, t);
        if (t + 1 < U.nt) STEP(pA0, pA1, pB0, pB1, t + 1);
    }
    if (my_nt == U.nt) {
        const LAS unsigned char* vb_ = vp0 + s2 * A_SLOT;
        if ((U.nt - 1) & 1) attn_step<ND0, NDB, false, true>(kf, qr, pA0, pA1, pB0, pB1, o, mrow, lrow, resc, wsf, kp0, vb_, r32, hi);
        else attn_step<ND0, NDB, false, true>(kf, qr, pB0, pB1, pA0, pA1, o, mrow, lrow, resc, wsf, kp0, vb_, r32, hi);
    }
#undef STEP
#undef STEP_TOP
#undef STEP_END
#undef RESC
#undef DMA_K
#undef DMA_V
#undef DMA16
    lrow += __shfl_xor(lrow, 32);
    if (hi == 0) wsf[r32] = active ? 1.0f / lrow : 0.f;
    asm volatile("s_waitcnt lgkmcnt(0)" ::: "memory");
    float il[16];
#pragma unroll
    for (int r = 0; r < 16; ++r) il[r] = wsf[crow(r, hi)];
    asm volatile("s_waitcnt lgkmcnt(0)" ::: "memory");
    if (DA) {
        LAS float* X = (LAS float*)(lds + A_X) + (size_t)wq * (NDB * 16 * 64);
        __syncthreads();
        if (comp == 1) {
#pragma unroll
            for (int d = 0; d < NDB; ++d)
#pragma unroll
                for (int r = 0; r < 16; ++r) X[(d * 16 + r) * 64 + lane] = o[d][r] * il[r];
        }
        __syncthreads();
        if (comp == 0 && active) {
            const float lam = ((const float*)(ws + WS_LAM))[0];
            float ss[16];
#pragma unroll
            for (int r = 0; r < 16; ++r) { ss[r] = 0.f;
#pragma unroll
                for (int d = 0; d < NDB; ++d) { const float x = o[d][r] * il[r] - lam * X[(d * 16 + r) * 64 + lane]; o[d][r] = x; ss[r] += x * x; } }
#pragma unroll
            for (int r = 0; r < 16; ++r) { float s = ss[r]; s += __shfl_xor(s, 1); s += __shfl_xor(s, 2); s += __shfl_xor(s, 4); s += __shfl_xor(s, 8); s += __shfl_xor(s, 16); ss[r] = rsqrtf(s * (1.0f / 128.0f) + RMS_EPS) * (1.0f - LAM_INIT); }
            const float* gh = a.in[10];
            const bf16_t* sz = (const bf16_t*)(ws + WS_SZA); bf16_t* ua = (bf16_t*)(ws + WS_UA);
#pragma unroll
            for (int d = 0; d < NDB; ++d) { const int col = U.h * 128 + d * 32 + r32; const float g = gh[d * 32 + r32];
#pragma unroll
                for (int r = 0; r < 16; ++r) { const size_t idx = (size_t)(myrow0 + crow(r, hi)) * 512 + col; ua[idx] = (bf16_t)(pk2(o[d][r] * ss[r] * g * bf2f(sz[idx]), 0.f) & 0xffffu); } }
        }
        __syncthreads();
    } else {
        if (active) {
            const bf16_t* sz = (const bf16_t*)(ws + WS_SZB); bf16_t* ub = (bf16_t*)(ws + WS_UB);
#pragma unroll
            for (int d = 0; d < NDB; ++d) { const int col = U.h * 64 + d * 32 + r32;
#pragma unroll
                for (int r = 0; r < 16; ++r) { const size_t idx = (size_t)(myrow0 + crow(r, hi)) * 512 + col; ub[idx] = (bf16_t)(pk2(o[d][r] * il[r] * bf2f(sz[idx]), 0.f) & 0xffffu); } }
        }
        __syncthreads();
    }
}
__device__ __forceinline__ void attn_phase(LAS unsigned char* lds, const Args& a, int cw) {
    const int G = gridDim.x, bid = blockIdx.x;
    if (G == 256) {
        const int xcd = bid & 7, i = bid >> 3;
        for (int s = 0; s < 17; ++s) {
            AUnit U; bool da;
            if (s < 8) { const int bh = xcd * 8 + s, b = bh >> 2, qb = (s & 1) ? 31 - i : i; da = true; U.h = bh & 3; U.qrow0 = b * SEQ + qb * 128; U.kbase = b * SEQ; U.nt = 2 * qb + 2; U.nrow = 128; }
            else if (s < 16) { const int k = s - 8, j = i & 15, bh = xcd * 16 + 2 * k + (i >> 4), b = bh >> 3, qb = (k & 1) ? 15 - j : j;
                da = false; U.h = bh & 7; U.qrow0 = b * SEQ + qb * 256; U.kbase = b * SEQ; U.nt = 4 * qb + 4; U.nrow = 256; }
            else { if (bid >= 96) break;
                if (bid < 32) { const int b = bid >> 2; da = true; U.h = bid & 3; U.qrow0 = MP + b * 64; U.kbase = MP + b * TS; U.nt = 17; U.nrow = 64; }
                else { const int jj = bid - 32, b = jj >> 3; da = false; U.h = jj & 7; U.qrow0 = MP + b * 64; U.kbase = MP + b * TS; U.nt = 17; U.nrow = 64; } }
            if (da) attn_unit<true>(lds, U, a); else attn_unit<false>(lds, U, a);
        }
        return;
    }
    unsigned* ctr = (unsigned*)(a.ws + WS_CTL) + cw;
    volatile LAS int* misc = (volatile LAS int*)(lds + LDS_MISC);
    for (;;) {
        if (threadIdx.x == 0) misc[0] = (int)atomicAdd(ctr, 1u);
        __syncthreads();
        const int it = misc[0];
        __syncthreads();
        if (it >= 4096 + 96) break;
        AUnit U; bool da;
        if (it < 4096) {
            const int r = it >> 7, j = it & 127;
            if (j < 64) { const int b = j >> 2, qb = 31 - r; da = true; U.h = j & 3; U.qrow0 = b * SEQ + qb * 128; U.kbase = b * SEQ; U.nt = 2 * qb + 2; U.nrow = 128; }
            else { const int bh = 2 * (j - 64) + (r & 1), b = bh >> 3, qb = 15 - (r >> 1); da = false; U.h = bh & 7; U.qrow0 = b * SEQ + qb * 256; U.kbase = b * SEQ; U.nt = 4 * qb + 4; U.nrow = 256; }
        } else { const int q = it - 4096;
            if (q < 32) { const int b = q >> 2; da = true; U.h = q & 3; U.qrow0 = MP + b * 64; U.kbase = MP + b * TS; U.nt = 17; U.nrow = 64; }
            else { const int jj = q - 32, b = jj >> 3; da = false; U.h = jj & 7; U.qrow0 = MP + b * 64; U.kbase = MP + b * TS; U.nt = 17; U.nrow = 64; } }
        if (da) attn_unit<true>(lds, U, a); else attn_unit<false>(lds, U, a);
    }
}

__global__ void __launch_bounds__(NTHREADS, 2) mega_fwd(Args a) {
    extern __shared__ __attribute__((aligned(16))) unsigned char lds_raw[];
    LAS unsigned char* lds = (LAS unsigned char*)lds_raw;
    cg::grid_group grid = cg::this_grid();
    unsigned char* ws = a.ws; float* out = a.out;
    const int G = gridDim.x, bid = blockIdx.x, tid = threadIdx.x, lane = tid & 63, wave = tid >> 6;
    const int lo = a.ph_lo, hi = a.ph_hi;
#define IN(k) (lo <= (k) && (k) < hi)
#define SEAM(k) do { if (IN(k) && IN((k) + 1)) grid.sync(); } while (0)
    const f32x2* cs_da = (const f32x2*)(ws + WS_ROPE_DA); const f32x2* cs_ml = (const f32x2*)(ws + WS_ROPE_ML);
    if (IN(0)) p0_prologue(a, lds);
    SEAM(0);
    if (IN(1)) {
        Epi1 E{ws, out, a.in[8], a.in[11], a.in[12]};
        pg8::Gemm g{(const bf16_t*)(ws + WS_XN), nullptr, (const bf16_t*)(ws + WS_WIN), nullptr, 1024};
        SchedGrid S; S.so.init(MT, NIN, G, bid); S.nt = 16;
        for (int rep = 0; rep < (PROBE_REP == 1 ? 2 : 1); ++rep)
        pg8::gemm_phase<Epi1, SchedGrid, true, true>(lds, g, S, E);
    }
    SEAM(1);
    if (IN(2)) {
        Epi2a Ea{(bf16_t*)(ws + WS_QM), (const float*)(ws + WS_SSQ), cs_ml};
        Epi2b Eb{(bf16_t*)(ws + WS_KN), (bf16_t*)(ws + WS_VM), (const float*)(ws + WS_SSKV)};
        pg8::Gemm g{(const bf16_t*)(ws + WS_CQ), (const bf16_t*)(ws + WS_CALL), (const bf16_t*)(ws + WS_WUQ), (const bf16_t*)(ws + WS_WUKV), 384};
        SchedP2 S{G, bid}; Epi2 E{Ea, Eb};
        pg8::gemm_phase<Epi2, SchedP2, true, true>(lds, g, S, E);
        for (int m = bid * NWAVES + wave; m < MT; m += G * NWAVES) {
            const float* p = (const float*)(ws + WS_SSKV) + (size_t)m * 8; float s = 0.f;
#pragma unroll
            for (int j = 0; j < 8; ++j) s += p[j];
            const float rstd = rsqrtf(s * (1.0f / 256.0f) + RMS_EPS);
            f32x4* r = (f32x4*)(m < MP ? out + O_LP + (size_t)m * 256 : out + O_LS + (size_t)(m - MP) * 256) + lane;
            f32x4 v = *r; v = v * rstd; *r = v;
        }
    }
    SEAM(2);
    if (IN(3)) { attn_phase(lds, a, 0); if (PROBE_REP == 3) { __syncthreads(); attn_phase(lds, a, 1); } }
    SEAM(3);
    if (IN(4)) {
        Epi3a Ea{(float*)(ws + WS_T), (const bf16_t*)(out + O_Y)};
        Epi3b Eb{(const float*)(ws + WS_T), (const bf16_t*)(out + O_Y), (bf16_t*)(ws + WS_MM)};
        pg8::Gemm g{(const bf16_t*)(ws + WS_UA), (const bf16_t*)(ws + WS_UB), (const bf16_t*)(ws + WS_WA), (const bf16_t*)(ws + WS_WB), 512};
        SchedTwoPass S; S.so.init(MT, 1024, G, bid); S.nt = 8; Epi3 E{Ea, Eb};
        pg8::gemm_phase<Epi3, SchedTwoPass, true, true>(lds, g, S, E);
    }
    SEAM(4);
    if (IN(5)) {
        Epi4 E{a.in[0], a.in[1], out + O_Y, (float*)(ws + WS_SSY)};
        pg8::Gemm g{(const bf16_t*)(ws + WS_MM), nullptr, (const bf16_t*)(ws + WS_WOUT), nullptr, 1024};
        SchedGrid S; S.so.init(MT, 1024, G, bid); S.nt = 16;
        pg8::gemm_phase<Epi4, SchedGrid, true, true>(lds, g, S, E);
    }
    SEAM(5);
    if (IN(6)) {
        f32x4 g[4];
#pragma unroll
        for (int j = 0; j < 4; ++j) g[j] = ((const f32x4*)a.in[19])[lane + 64 * j];
        for (int m = bid * NWAVES + wave; m < MT; m += G * NWAVES) {
            const float* p = (const float*)(ws + WS_SSY) + (size_t)m * 32;
            const float s = wave_sum(lane < 32 ? p[lane] : 0.f);
            const float rstd = rsqrtf(s * (1.0f / 1024.0f) + RMS_EPS);
            f32x4* r = (f32x4*)(out + O_Y + (size_t)m * 1024);
#pragma unroll
            for (int j = 0; j < 4; ++j) { f32x4 v = r[lane + 64 * j]; v = v * rstd * g[j]; r[lane + 64 * j] = v; }
        }
    }
#undef IN
#undef SEAM
}

extern "C" void kernel_launch(void* const* d_in, const int* in_sizes, int n_in, void* d_out, int out_size, void* d_ws, size_t ws_size, hipStream_t stream) {
    static int grid = 0;
    if (grid == 0) {
        if (n_in != 20 || (size_t)out_size != O_END || ws_size < WS_END) { fprintf(stderr, "kernel_launch: unexpected shapes (n_in %d out %d ws %zu)\n", n_in, out_size, ws_size); grid = -1; return; }
        int dev = 0, cus = 0, per_cu = 0;
        hipGetDevice(&dev); hipDeviceGetAttribute(&cus, hipDeviceAttributeMultiprocessorCount, dev);
        if (hipFuncSetAttribute((const void*)mega_fwd, hipFuncAttributeMaxDynamicSharedMemorySize, LDS_BYTES) != hipSuccess) { fprintf(stderr, "kernel_launch: hipFuncSetAttribute failed\n"); grid = -1; return; }
        if (hipOccupancyMaxActiveBlocksPerMultiprocessor(&per_cu, (const void*)mega_fwd, NTHREADS, LDS_BYTES) != hipSuccess || per_cu < 1) { fprintf(stderr, "kernel_launch: occupancy query says %d\n", per_cu); (void)hipGetLastError(); grid = -1; return; }
        grid = cus;
        if (grid > cus * per_cu) grid = cus * per_cu;
    }
    if (grid < 0) return;
    Args a{};
    for (int i = 0; i < 20; ++i) a.in[i] = (const float*)d_in[i];
    a.out = (float*)d_out; a.ws = (unsigned char*)d_ws;
#if MK_N_LAUNCHES == 1
    a.ph_lo = 0; a.ph_hi = 7;
    void* args[] = {&a};
    hipError_t e = hipLaunchCooperativeKernel((const void*)mega_fwd, dim3(grid), dim3(NTHREADS), args, LDS_BYTES, stream);
    if (e != hipSuccess) fprintf(stderr, "cooperative launch failed: %s (grid %d)\n", hipGetErrorString(e), grid);
#else
    for (int p = 0; p < 7; ++p) { a.ph_lo = p; a.ph_hi = p + 1; hipLaunchKernelGGL(mega_fwd, dim3(grid), dim3(NTHREADS), LDS_BYTES, stream, a); }
#endif
}
```

```cpp
#include <hip/hip_runtime.h>
#include <hip/hip_cooperative_groups.h>
#include <cstdio>
#include <cstdint>
namespace cg = cooperative_groups;

#ifndef MK_N_LAUNCHES
#define MK_N_LAUNCHES 1
#endif

#ifndef PROBE_REP
#define PROBE_REP -1
#endif
#define LAS __attribute__((address_space(3)))
typedef unsigned short bf16_t;
typedef short bf16x8 __attribute__((ext_vector_type(8)));
typedef short s16x4 __attribute__((ext_vector_type(4)));
typedef float f32x2 __attribute__((ext_vector_type(2)));
typedef float f32x4 __attribute__((ext_vector_type(4)));
typedef float f32x16 __attribute__((ext_vector_type(16)));
typedef unsigned u32x2 __attribute__((ext_vector_type(2)));
typedef unsigned u32x4 __attribute__((ext_vector_type(4)));
typedef __bf16 bf16x2_t __attribute__((ext_vector_type(2)));

constexpr int DM = 1024, NB = 16, SEQ = 4096, DECB = 8, DECS = 64, PAST = 1024;
constexpr int MP = NB * SEQ;
constexpr int MS = DECB * DECS;
constexpr int MT = MP + MS;
constexpr int TS = PAST + DECS;
constexpr int KR = MP + DECB * TS;
constexpr int NIN = 5376;
constexpr float RMS_EPS = 1e-6f;
constexpr float LOG2E = 1.4426950408889634f;
constexpr float C2A = 0.125f * LOG2E;
constexpr float C2M = 0.10206207261596575f * LOG2E;
constexpr float LAM_INIT = 0.2f;
constexpr size_t O_Y = 0;
constexpr size_t O_KP = (size_t)MT * 1024;
constexpr size_t O_VP = O_KP + (size_t)MP * 512;
constexpr size_t O_LP = O_VP + (size_t)MP * 512;
constexpr size_t O_RP = O_LP + (size_t)MP * 256;
constexpr size_t O_KS = O_RP + (size_t)MP * 32;
constexpr size_t O_VS = O_KS + (size_t)MS * 512;
constexpr size_t O_LS = O_VS + (size_t)MS * 512;
constexpr size_t O_RS = O_LS + (size_t)MS * 256;
constexpr size_t O_END = O_RS + (size_t)MS * 32;
constexpr size_t MiB = 1u << 20;
constexpr size_t WS_CTL = 0, WS_LAM = 4096, WS_ROPE_DA = 8192, WS_ROPE_ML = WS_ROPE_DA + 4096 * 8 * 8;
constexpr size_t WS_WIN = 1 * MiB, WS_WUQ = 12 * MiB, WS_WUKV = 13 * MiB, WS_WA = 14 * MiB, WS_WB = 15 * MiB, WS_WOUT = 16 * MiB;
constexpr size_t WS_SSQ = 18 * MiB, WS_SSKV = 23 * MiB, WS_SSY = 26 * MiB;
constexpr size_t WS_XN = 36 * MiB;
constexpr size_t WS_UA = WS_XN, WS_UB = WS_XN + (size_t)MT * 512 * 2;
constexpr size_t WS_QA = 166 * MiB, WS_KA = 231 * MiB, WS_VA = 304 * MiB, WS_SZA = 377 * MiB;
constexpr size_t WS_T = WS_QA;
constexpr size_t WS_SZB = 442 * MiB, WS_CQ = 507 * MiB, WS_CALL = 556 * MiB, WS_KR = 611 * MiB;
constexpr size_t WS_QM = 616 * MiB, WS_KN = 713 * MiB, WS_VM = 786 * MiB;
constexpr size_t WS_MM = WS_QM;
constexpr size_t WS_END = 859 * MiB;
static_assert(WS_XN + (size_t)MT * 1024 * 2 <= WS_QA && WS_T + (size_t)MT * 1024 * 4 <= WS_SZB && WS_MM + (size_t)MT * 1024 * 2 <= WS_VM + (size_t)KR * 512 * 2, "ws map");
static_assert(WS_QA + (size_t)MT * 512 * 2 <= WS_KA && WS_KA + (size_t)KR * 512 * 2 <= WS_VA && WS_VA + (size_t)KR * 512 * 2 <= WS_SZA && WS_SZA + (size_t)MT * 512 * 2 <= WS_SZB, "ws map 2");
static_assert(WS_SZB + (size_t)MT * 512 * 2 <= WS_CQ && WS_CQ + (size_t)MT * 384 * 2 <= WS_CALL && WS_CALL + (size_t)KR * 384 * 2 <= WS_KR && WS_KR + (size_t)KR * 32 * 2 <= WS_QM, "ws map 3");
static_assert(WS_QM + (size_t)MT * 768 * 2 <= WS_KN && WS_KN + (size_t)KR * 512 * 2 <= WS_VM && WS_VM + (size_t)KR * 512 * 2 <= WS_END, "ws map 4");
static_assert(WS_WIN + (size_t)NIN * 1024 * 2 <= WS_WUQ && WS_SSQ + (size_t)MT * 16 * 4 <= WS_SSKV && WS_SSKV + (size_t)MT * 8 * 4 <= WS_SSY && WS_SSY + (size_t)MT * 32 * 4 <= WS_XN, "ws map 5");

constexpr int NTHREADS = 512, NWAVES = 8;
constexpr int LDS_BYTES = 139264;
constexpr int LDS_MISC = 135168;

__constant__ float c_inv_da[8] = {1.0f, 0.1939227432012558f, 0.03760603070259094f, 0.007292664609849453f, 0.0014142135623842478f, 0.00027424818836152554f, 5.318296098266728e-05f, 1.0313386155758053e-05f};
__constant__ float c_inv_ml[16] = {1.0f, 0.44036659598350525f, 0.1939227432012558f, 0.08539710193872452f, 0.03760603070259094f, 0.01656043902039528f, 0.007292664609849453f, 0.0032114458736032248f,
                                   0.0014142135623842478f, 0.000622772378847003f, 0.00027424818836152554f, 0.00012076973507646471f, 5.318296098266728e-05f, 2.34199997066753e-05f, 1.0313386155758053e-05f, 4.541670477919979e-06f};

__device__ __forceinline__ unsigned pk2(float lo, float hi) { f32x2 v = {lo, hi}; bf16x2_t b = __builtin_convertvector(v, bf16x2_t); return __builtin_bit_cast(unsigned, b); }
__device__ __forceinline__ float bflo(unsigned u) { return __builtin_bit_cast(float, u << 16); }
__device__ __forceinline__ float bfhi(unsigned u) { return __builtin_bit_cast(float, u & 0xffff0000u); }
__device__ __forceinline__ float bf2f(bf16_t h) { return __builtin_bit_cast(float, (unsigned)h << 16); }
__device__ __forceinline__ u32x4 pack8(const float* v) { u32x4 w; w.x = pk2(v[0], v[1]); w.y = pk2(v[2], v[3]); w.z = pk2(v[4], v[5]); w.w = pk2(v[6], v[7]); return w; }
__device__ __forceinline__ void unpack8(u32x4 w, float* v) { v[0] = bflo(w.x); v[1] = bfhi(w.x); v[2] = bflo(w.y); v[3] = bfhi(w.y); v[4] = bflo(w.z); v[5] = bfhi(w.z); v[6] = bflo(w.w); v[7] = bfhi(w.w); }
__device__ __forceinline__ int tok_pos(int row) { return row < MP ? (row & (SEQ - 1)) : PAST + ((row - MP) & (DECS - 1)); }
__device__ __forceinline__ int tok_krow(int row) { return row < MP ? row : MP + ((row - MP) >> 6) * TS + PAST + ((row - MP) & 63); }
__device__ __forceinline__ float wave_sum(float v) {
#pragma unroll
    for (int o = 1; o < 64; o <<= 1) v += __shfl_xor(v, o);
    return v;
}
__device__ __forceinline__ float sigmoidf_(float x) { return 1.0f / (1.0f + __expf(-x)); }
__device__ __forceinline__ float siluf_(float x) { return x / (1.0f + __expf(-x)); }
__device__ __forceinline__ int crow(int r, int hi) { return (r & 3) + 8 * (r >> 2) + 4 * hi; }
__host__ __device__ __forceinline__ int perm32(int rho) { const int n = rho >> 4, i = rho & 15; return 8 * (i >> 2) + 4 * n + (i & 3); }

struct Args {
    const float* in[20]; float* out; unsigned char* ws; int ph_lo, ph_hi;
};

namespace pg8 {
#define PG8_LAS __attribute__((address_space(3)))
constexpr int BM = 256, BK = 64, HALF = 128, HTB = HALF * BK * 2  , STAGE_BYTES = 8 * HTB, NXCD = 8, WGM = 8;
__host__ __device__ __forceinline__ int lds_byte(int r, int c) { const int st = (r >> 4) * 2 + (c >> 5), rr = r & 15, cc = c & 31, ob = rr * 64 + cc * 2; return st * 1024 + (ob ^ (((ob >> 9) & 1) << 5)); }
__host__ __device__ __forceinline__ void stage_rc(int b, int& R, int& C) { const int st = b / 1024, sb = b % 1024, swz = sb ^ (((sb >> 9) & 1) << 5); R = (st >> 1) * 16 + swz / 64; C = (st & 1) * 32 + (swz % 64) / 2; }
struct Unit { int pm, pn, src, nt; };
struct Gemm { const bf16_t *A0, *A1, *B0, *B1; int K; };
struct StaticOrder {
    int nM, nN, nwg, G, c;
    __host__ __device__ void init(int M, int N, int G_, int c_) { nM = M / BM; nN = N / BM; nwg = nM * nN; G = G_; c = c_; }
    __host__ __device__ bool next(int i, Unit& u) const {
        const long L = (long)i * G + c; if (L >= nwg) return false;
        int wgid = (int)L; { const int q = nwg / NXCD, r = nwg % NXCD, xcd = wgid % NXCD, off = wgid / NXCD; wgid = (xcd < r ? xcd * (q + 1) : r * (q + 1) + (xcd - r) * q) + off; }
        const int nig = WGM * nN, gid = wgid / nig, fm = gid * WGM, gsz = (nM - fm) < WGM ? (nM - fm) : WGM;
        u.pm = fm + ((wgid % nig) % gsz); u.pn = (wgid % nig) / gsz; return true;
    }
};
template <class Epi, class Sched, bool ALIGN_EPI = false, bool SP2 = false>
__device__ __forceinline__ void gemm_phase(PG8_LAS unsigned char* lds, const Gemm g, const Sched& S, const Epi& E) {
    const int tid = threadIdx.x, wid = __builtin_amdgcn_readfirstlane(tid >> 6), lane = tid & 63, wr = wid >> 2, wc = wid & 3, fr = lane & 15, fq = lane >> 4;
    const int K = g.K;
    unsigned voffA[2], voffB[2];
#pragma unroll
    for (int i = 0; i < 2; ++i) { int R, C; stage_rc(tid * 16 + i * 8192, R, C); const int Rb = Epi::PERM ? ((R & ~31) + perm32(R & 31)) : R;
        voffA[i] = (unsigned)(R * K + C) * 2u; voffB[i] = (unsigned)(Rb * K + C) * 2u; }
    const size_t kstep = (size_t)(BK * 2);
    const size_t hstep = (size_t)HALF * K * 2;
    const size_t tstep = 2 * hstep;
    const unsigned ldsw = (unsigned)wid * 1024u;
    const int aoff = lds_byte(wr * 64 + fr, fq * 8), boff = lds_byte(wc * 32 + fr, fq * 8);
#define PG8_SA(b, h) (((b) * 2 + (h)) * HTB)
#define PG8_SB(b, h) ((4 + (b) * 2 + (h)) * HTB)
#define PG8_STAGE(bufoff, gbase, voff) do { _Pragma("unroll") for (int _i = 0; _i < 2; ++_i) \
        __builtin_amdgcn_global_load_lds((const unsigned*)((const char*)(gbase) + (voff)[_i]), (PG8_LAS unsigned*)(lds + (bufoff) + ldsw + _i * 8192), 16, 0, 0); } while (0)
#define PG8_LDA(dst, b, h) do { _Pragma("unroll") for (int m = 0; m < 4; ++m) _Pragma("unroll") for (int k = 0; k < 2; ++k) dst[m][k] = *(const PG8_LAS bf16x8*)(lds + PG8_SA(b, h) + aoff + m * 2048 + k * 1024); } while (0)
#define PG8_LDB(dst, b, h) do { _Pragma("unroll") for (int n = 0; n < 2; ++n) _Pragma("unroll") for (int k = 0; k < 2; ++k) dst[n][k] = *(const PG8_LAS bf16x8*)(lds + PG8_SB(b, h) + boff + n * 2048 + k * 1024); } while (0)
#define PG8_MMA(ai, bj, At, Bt) do { __builtin_amdgcn_s_setprio(1); _Pragma("unroll") for (int m = 0; m < 4; ++m) _Pragma("unroll") for (int n = 0; n < 2; ++n) _Pragma("unroll") for (int k = 0; k < 2; ++k) \
        acc[ai][bj][m][n] = __builtin_amdgcn_mfma_f32_16x16x32_bf16(Bt[n][k], At[m][k], acc[ai][bj][m][n], 0, 0, 0); __builtin_amdgcn_s_setprio(0); } while (0)
#define PG8_WAIT_V(n) asm volatile("s_waitcnt vmcnt(" #n ")" ::: "memory")
#define PG8_WAIT_L(n) asm volatile("s_waitcnt lgkmcnt(" #n ")" ::: "memory")
#define PG8_BAR __builtin_amdgcn_s_barrier()
#define PG8_SCHED __builtin_amdgcn_sched_barrier(0)
    Unit cur, nxt; int ui = 0;
    if (!S.next(0, cur)) return;
    f32x4 acc[2][2][4][2];
#pragma unroll
    for (int a = 0; a < 2; ++a)
#pragma unroll
        for (int b = 0; b < 2; ++b)
#pragma unroll
            for (int m = 0; m < 4; ++m)
#pragma unroll
                for (int n = 0; n < 2; ++n) acc[a][b][m][n] = (f32x4){0.f, 0.f, 0.f, 0.f};
    bf16x8 At[4][2], B0[2][2], B1[2][2];
    const char* cA = (const char*)(cur.src ? g.A1 : g.A0) + (size_t)cur.pm * tstep; const char* cB = (const char*)(cur.src ? g.B1 : g.B0) + (size_t)cur.pn * tstep;
    S.a_ready(cur);
    if constexpr (SP2) {
        PG8_STAGE(PG8_SB(0, 0), cB, voffB); PG8_STAGE(PG8_SB(0, 1), cB + hstep, voffB); PG8_STAGE(PG8_SA(0, 0), cA, voffA); PG8_STAGE(PG8_SA(0, 1), cA + hstep, voffA);
        if (wr == 1) PG8_BAR;
        PG8_WAIT_V(2); PG8_BAR;
        PG8_STAGE(PG8_SB(1, 0), cB + kstep, voffB); PG8_STAGE(PG8_SA(1, 0), cA + kstep, voffA); PG8_STAGE(PG8_SB(1, 1), cB + hstep + kstep, voffB);
        PG8_WAIT_V(6); PG8_BAR;
    } else {
        PG8_STAGE(PG8_SB(0, 0), cB, voffB); PG8_STAGE(PG8_SA(0, 0), cA, voffA); PG8_STAGE(PG8_SB(0, 1), cB + hstep, voffB); PG8_STAGE(PG8_SA(0, 1), cA + hstep, voffA);
        if (wr == 1) PG8_BAR;
        PG8_WAIT_V(4); PG8_BAR;
        PG8_STAGE(PG8_SB(1, 0), cB + kstep, voffB); PG8_STAGE(PG8_SA(1, 0), cA + kstep, voffA); PG8_STAGE(PG8_SB(1, 1), cB + hstep + kstep, voffB);
        PG8_WAIT_V(6); PG8_BAR;
    }
    for (;;) {
        const bool has_next = S.next(ui + 1, nxt);
        const char* nA = has_next ? (const char*)(nxt.src ? g.A1 : g.A0) + (size_t)nxt.pm * tstep : cA; const char* nB = has_next ? (const char*)(nxt.src ? g.B1 : g.B0) + (size_t)nxt.pn * tstep : cB;
        const int nt = cur.nt;
        for (int t = 0; t < nt; t += 2) {
            const bool last = (t == nt - 2);
            const char* a1 = cA + (size_t)(t + 1) * kstep;
            const char* a2 = last ? nA : cA + (size_t)(t + 2) * kstep; const char* b2 = last ? nB : cB + (size_t)(t + 2) * kstep;
            const char* a3 = a2 + kstep; const char* b3 = b2 + kstep;
            if (last && has_next) S.a_ready(nxt);
            if constexpr (SP2) {
            PG8_LDB(B0, 0, 0); PG8_LDB(B1, 0, 1); PG8_SCHED; PG8_LDA(At, 0, 0); PG8_STAGE(PG8_SA(1, 1), a1 + hstep, voffA);
            PG8_WAIT_V(8); PG8_WAIT_L(0); PG8_BAR; PG8_MMA(0, 0, At, B0); PG8_MMA(0, 1, At, B1); PG8_BAR; PG8_SCHED;
            PG8_LDA(At, 0, 1); PG8_STAGE(PG8_SB(0, 0), b2, voffB); PG8_STAGE(PG8_SB(0, 1), b2 + hstep, voffB); PG8_STAGE(PG8_SA(0, 0), a2, voffA);
            PG8_WAIT_V(8); PG8_WAIT_L(0); PG8_BAR; PG8_MMA(1, 0, At, B0); PG8_MMA(1, 1, At, B1); PG8_BAR; PG8_SCHED;
            PG8_LDB(B0, 1, 0); PG8_LDB(B1, 1, 1); PG8_SCHED; PG8_LDA(At, 1, 0); PG8_STAGE(PG8_SA(0, 1), a2 + hstep, voffA);
            PG8_WAIT_V(8); PG8_WAIT_L(0); PG8_BAR; PG8_MMA(0, 0, At, B0); PG8_MMA(0, 1, At, B1); PG8_BAR; PG8_SCHED;
            PG8_LDA(At, 1, 1); PG8_STAGE(PG8_SB(1, 0), b3, voffB); PG8_STAGE(PG8_SB(1, 1), b3 + hstep, voffB); PG8_STAGE(PG8_SA(1, 0), a3, voffA);
            PG8_WAIT_V(8); PG8_WAIT_L(0); PG8_BAR; PG8_MMA(1, 0, At, B0); PG8_MMA(1, 1, At, B1); PG8_BAR; PG8_SCHED;
            } else {
            PG8_LDB(B0, 0, 0); PG8_SCHED; PG8_LDA(At, 0, 0); PG8_STAGE(PG8_SA(1, 1), a1 + hstep, voffA);
            PG8_WAIT_L(8); PG8_BAR; PG8_WAIT_L(0); PG8_MMA(0, 0, At, B0); PG8_BAR; PG8_SCHED;
            PG8_LDB(B1, 0, 1); PG8_STAGE(PG8_SB(0, 0), b2, voffB);
            PG8_BAR; PG8_WAIT_L(0); PG8_MMA(0, 1, At, B1); PG8_BAR;
            PG8_LDA(At, 0, 1); PG8_STAGE(PG8_SA(0, 0), a2, voffA);
            PG8_BAR; PG8_WAIT_L(0); PG8_MMA(1, 0, At, B0); PG8_BAR; PG8_SCHED;
            PG8_STAGE(PG8_SB(0, 1), b2 + hstep, voffB);
            PG8_WAIT_V(6); PG8_BAR; PG8_MMA(1, 1, At, B1); PG8_BAR;
            PG8_LDB(B0, 1, 0); PG8_SCHED; PG8_LDA(At, 1, 0); PG8_STAGE(PG8_SA(0, 1), a2 + hstep, voffA);
            PG8_WAIT_L(8); PG8_BAR; PG8_WAIT_L(0); PG8_MMA(0, 0, At, B0); PG8_BAR; PG8_SCHED;
            PG8_LDB(B1, 1, 1); PG8_STAGE(PG8_SB(1, 0), b3, voffB);
            PG8_BAR; PG8_WAIT_L(0); PG8_MMA(0, 1, At, B1); PG8_BAR;
            PG8_LDA(At, 1, 1); PG8_STAGE(PG8_SA(1, 0), a3, voffA);
            PG8_BAR; PG8_WAIT_L(0); PG8_MMA(1, 0, At, B0); PG8_BAR; PG8_SCHED;
            PG8_STAGE(PG8_SB(1, 1), b3 + hstep, voffB);
            PG8_WAIT_V(6); PG8_BAR; PG8_MMA(1, 1, At, B1); PG8_BAR;
            }
        }
        if constexpr (ALIGN_EPI) { if (wr == 0) PG8_BAR; }
        if constexpr (!Epi::AFTER_DRAIN) { int fr_ = fr, fq_ = fq; asm volatile("" : "+v"(fr_), "+v"(fq_));
            E(acc, cur, wr, wc, fr_, fq_); S.done(cur); }
        if (!has_next) break;
        if (!(Epi::CHAIN && cur.src == 0)) {
#pragma unroll
        for (int a = 0; a < 2; ++a)
#pragma unroll
            for (int b = 0; b < 2; ++b)
#pragma unroll
                for (int m = 0; m < 4; ++m)
#pragma unroll
                    for (int n = 0; n < 2; ++n) acc[a][b][m][n] = (f32x4){0.f, 0.f, 0.f, 0.f};
        }
        cur = nxt; cA = nA; cB = nB; ++ui;
        if constexpr (ALIGN_EPI) { if (wr == 1) PG8_BAR; }
    }
    PG8_WAIT_V(0);
    if constexpr (!ALIGN_EPI) { if (wr == 0) PG8_BAR; }
    PG8_BAR;
    if constexpr (Epi::AFTER_DRAIN) { E.fused(acc, cur, wr, wc, fr, fq, lds, wid, lane); S.done(cur); }
#undef PG8_SA
#undef PG8_SB
#undef PG8_STAGE
#undef PG8_LDA
#undef PG8_LDB
#undef PG8_MMA
#undef PG8_WAIT_V
#undef PG8_WAIT_L
#undef PG8_BAR
#undef PG8_SCHED
}
}
using pg8::Unit;

#define EPI_FENCE() asm volatile("" ::: "memory")
#define EPI_HALF_BEGIN _Pragma("unroll") for (int ai = 0; ai < 2; ++ai) {
#define EPI_HALF_END }
#define EPI_M_BEGIN _Pragma("unroll") for (int m = 0; m < 4; ++m) { const int row = u.pm * 256 + ai * 128 + wr * 64 + m * 16 + fr;
#define EPI_M_END }
#define EPI_ROW(ai, m) (u.pm * 256 + (ai) * 128 + wr * 64 + (m) * 16 + fr)
#define EPI_BJ_BEGIN \
    _Pragma("unroll") for (int bj = 0; bj < 2; ++bj) { const int c8 = u.pn * 256 + bj * 128 + wc * 32 + fq * 8; float v[8]; \
        v[0] = acc[ai][bj][m][0][0]; v[1] = acc[ai][bj][m][0][1]; v[2] = acc[ai][bj][m][0][2]; v[3] = acc[ai][bj][m][0][3]; \
        v[4] = acc[ai][bj][m][1][0]; v[5] = acc[ai][bj][m][1][1]; v[6] = acc[ai][bj][m][1][2]; v[7] = acc[ai][bj][m][1][3];
#define EPI_BJ_END }

__device__ __forceinline__ void st8f(float* p, const float* v) { *(f32x4*)p = (f32x4){v[0], v[1], v[2], v[3]}; *(f32x4*)(p + 4) = (f32x4){v[4], v[5], v[6], v[7]}; }
__device__ __forceinline__ void ld8f(const float* p, float* v) { const f32x4 a = *(const f32x4*)p, b = *(const f32x4*)(p + 4); v[0] = a[0]; v[1] = a[1]; v[2] = a[2]; v[3] = a[3]; v[4] = b[0]; v[5] = b[1]; v[6] = b[2]; v[7] = b[3]; }
template <int XM> __device__ __forceinline__ void rope8(float* v, bool active, bool first, const f32x2* cs) {
    float pr[8];
#pragma unroll
    for (int j = 0; j < 8; ++j) pr[j] = __shfl_xor(v[j], XM);
    if (active) {
#pragma unroll
        for (int j = 0; j < 8; ++j) { const f32x2 c = cs[j]; v[j] = first ? v[j] * c.x - pr[j] * c.y : v[j] * c.x + pr[j] * c.y; }
    }
}
__device__ __forceinline__ void ldcs8(const f32x2* p, f32x2* cs) {
#pragma unroll
    for (int j = 0; j < 4; ++j) { const f32x4 t = ((const f32x4*)p)[j]; cs[2 * j] = (f32x2){t[0], t[1]}; cs[2 * j + 1] = (f32x2){t[2], t[3]}; }
}

struct Epi1 {
    static constexpr bool PERM = true, AFTER_DRAIN = false, CHAIN = false;
    unsigned char* ws; float* out; const float *gate_b, *gq, *gkv;
    __device__ __forceinline__ void operator()(f32x4 (&acc)[2][2][4][2], const Unit& u, int wr, int wc, int fr, int fq) const {
        const int pn = u.pn;
        bf16_t* const QA = (bf16_t*)(ws + WS_QA); bf16_t* const KA = (bf16_t*)(ws + WS_KA); bf16_t* const VA = (bf16_t*)(ws + WS_VA); bf16_t* const SZA = (bf16_t*)(ws + WS_SZA); bf16_t* const SZB = (bf16_t*)(ws + WS_SZB);
        bf16_t* const G = (bf16_t*)(out + O_Y); bf16_t* const CQ = (bf16_t*)(ws + WS_CQ); bf16_t* const CALL = (bf16_t*)(ws + WS_CALL); bf16_t* const KRB = (bf16_t*)(ws + WS_KR);
        float* const SSQ = (float*)(ws + WS_SSQ); float* const SSKV = (float*)(ws + WS_SSKV); const f32x2* const cs_da = (const f32x2*)(ws + WS_ROPE_DA); const f32x2* const cs_ml = (const f32x2*)(ws + WS_ROPE_ML);
        if (pn < 4) {
            const bool isq = pn < 2, ropew = (wc & 1) == 0;
#pragma unroll
            for (int rb = 0; rb < 4; ++rb) {
                const int ai = rb >> 1;
                f32x2 cs[2][8];
                if (ropew) {
#pragma unroll
                    for (int mm = 0; mm < 2; ++mm) ldcs8(cs_da + tok_pos(EPI_ROW(ai, 2 * (rb & 1) + mm)) * 8, cs[mm]);
                }
                EPI_FENCE();
#pragma unroll
                for (int mm = 0; mm < 2; ++mm) { const int m = 2 * (rb & 1) + mm; const int row = EPI_ROW(ai, m); const int kr = tok_krow(row);
                    float* orow = row < MP ? out + O_KP + (size_t)row * 512 : out + O_KS + (size_t)(row - MP) * 512;
                EPI_BJ_BEGIN
                    if (ropew) rope8<16>(v, fq < 2, fq == 0, cs[mm]);
                    if (isq) {
#pragma unroll
                        for (int j = 0; j < 8; ++j) v[j] *= C2A;
                        *(u32x4*)(QA + (size_t)row * 512 + c8) = pack8(v);
                    } else { const int c = c8 - 512; st8f(orow + c, v); *(u32x4*)(KA + (size_t)kr * 512 + c) = pack8(v); }
                EPI_BJ_END
                }
                EPI_FENCE();
            }
        } else if (pn < 6) {
            EPI_HALF_BEGIN EPI_M_BEGIN const int kr = tok_krow(row);
                float* orow = row < MP ? out + O_VP + (size_t)row * 512 : out + O_VS + (size_t)(row - MP) * 512;
            EPI_BJ_BEGIN const int c = c8 - 1024;
                st8f(orow + c, v);
                *(u32x4*)(VA + (size_t)kr * 512 + c) = pack8(v);
            EPI_BJ_END EPI_M_END EPI_HALF_END
        } else if (pn < 10) {
            bf16_t* dst = pn < 8 ? SZA : SZB; const int cb = pn < 8 ? 1536 : 2048;
            EPI_HALF_BEGIN EPI_M_BEGIN
            EPI_BJ_BEGIN const int c = c8 - cb;
#pragma unroll
                for (int j = 0; j < 8; ++j) v[j] = siluf_(v[j]);
                *(u32x4*)(dst + (size_t)row * 512 + c) = pack8(v);
            EPI_BJ_END EPI_M_END EPI_HALF_END
        } else if (pn < 18) {
            float b[2][8];
#pragma unroll
            for (int bj = 0; bj < 2; ++bj) ld8f(gate_b + (pn * 256 + bj * 128 + wc * 32 + fq * 8 - 2560), b[bj]);
            const float flo = pn >= 14 ? 1e-30f : 0.f;
            EPI_FENCE();
            EPI_HALF_BEGIN EPI_M_BEGIN
            EPI_BJ_BEGIN const int c = c8 - 2560;
#pragma unroll
                for (int j = 0; j < 8; ++j) v[j] = __builtin_fmaxf(sigmoidf_(v[j] + b[bj][j]), flo);
                *(u32x4*)(G + (size_t)row * 2048 + c) = pack8(v);
            EPI_BJ_END EPI_M_END EPI_HALF_END
        } else if (pn == 20) {
            float g[2][8];
#pragma unroll
            for (int bj = 0; bj < 2; ++bj) ld8f(gkv + (bj * 128 + wc * 32 + fq * 8), g[bj]);
            EPI_FENCE();
            EPI_HALF_BEGIN EPI_M_BEGIN const int kr = tok_krow(row);
                float* orow = row < MP ? out + O_LP + (size_t)row * 256 : out + O_LS + (size_t)(row - MP) * 256;
            EPI_BJ_BEGIN const int c = c8 - 5120; float ss = 0.f;
#pragma unroll
                for (int j = 0; j < 8; ++j) { ss += v[j] * v[j]; v[j] *= g[bj][j]; }
                ss += __shfl_xor(ss, 16); ss += __shfl_xor(ss, 32);
                if (fq == 0) SSKV[(size_t)row * 8 + bj * 4 + wc] = ss;
                st8f(orow + c, v);
                *(u32x4*)(CALL + (size_t)kr * 384 + c) = pack8(v);
            EPI_BJ_END EPI_M_END EPI_HALF_END
        } else {
            float g[2][8];
#pragma unroll
            for (int bj = 0; bj < 2; ++bj) { if (pn == 18 || bj == 0) ld8f(gq + ((pn - 18) * 256 + bj * 128 + wc * 32 + fq * 8), g[bj]); }
            const bool krw = pn == 19 && wc == 0;
#pragma unroll
            for (int rb = 0; rb < 4; ++rb) {
                const int ai = rb >> 1;
                f32x2 cs[2][8];
                if (krw) {
#pragma unroll
                    for (int mm = 0; mm < 2; ++mm) ldcs8(cs_ml + tok_pos(EPI_ROW(ai, 2 * (rb & 1) + mm)) * 16 + (fq & 1) * 8, cs[mm]);
                }
                EPI_FENCE();
#pragma unroll
                for (int mm = 0; mm < 2; ++mm) { const int m = 2 * (rb & 1) + mm; const int row = EPI_ROW(ai, m); const int kr = tok_krow(row);
                EPI_BJ_BEGIN
                    if (pn == 18 || bj == 0) {
                        const int c = c8 - 4608; float ss = 0.f;
#pragma unroll
                        for (int j = 0; j < 8; ++j) { ss += v[j] * v[j]; v[j] *= g[bj][j]; }
                        ss += __shfl_xor(ss, 16); ss += __shfl_xor(ss, 32);
                        if (fq == 0) SSQ[(size_t)row * 16 + (pn - 18) * 8 + bj * 4 + wc] = ss;
                        *(u32x4*)(CQ + (size_t)row * 384 + c) = pack8(v);
                    } else if (wc == 0) {
                        const int c = fq * 8;
                        rope8<32>(v, true, fq < 2, cs[mm]);
                        float* orow = row < MP ? out + O_RP + (size_t)row * 32 : out + O_RS + (size_t)(row - MP) * 32;
                        st8f(orow + c, v);
                        *(u32x4*)(KRB + (size_t)kr * 32 + c) = pack8(v);
                    }
                EPI_BJ_END
                }
                EPI_FENCE();
            }
        }
    }
};
struct Epi2a {
    static constexpr bool PERM = true, AFTER_DRAIN = false, CHAIN = false;
    bf16_t* QM; const float* SSQ; const f32x2* cs_ml;
    __device__ __forceinline__ void operator()(f32x4 (&acc)[2][2][4][2], const Unit& u, int wr, int wc, int fr, int fq) const {
        const int g0 = u.pn * 8 + wc; const bool r0 = g0 % 3 == 2, r1 = (g0 + 4) % 3 == 2;
        EPI_HALF_BEGIN
            float sc[4];
            {   f32x4 t[4][3];
#pragma unroll
                for (int m = 0; m < 4; ++m) { const f32x4* p = (const f32x4*)(SSQ + (size_t)EPI_ROW(ai, m) * 16); t[m][0] = p[0]; t[m][1] = p[1]; t[m][2] = p[2]; }
                EPI_FENCE();
#pragma unroll
                for (int m = 0; m < 4; ++m) { const f32x4 s4 = t[m][0] + t[m][1] + t[m][2]; sc[m] = rsqrtf(((s4[0] + s4[1]) + (s4[2] + s4[3])) * (1.0f / 384.0f) + RMS_EPS) * C2M; } }
#pragma unroll
            for (int hb = 0; hb < 2; ++hb) {
                f32x2 cs[2][8];
                if (r0 || r1) {
#pragma unroll
                    for (int mm = 0; mm < 2; ++mm) ldcs8(cs_ml + tok_pos(EPI_ROW(ai, 2 * hb + mm)) * 16 + (fq & 1) * 8, cs[mm]);
                }
                EPI_FENCE();
#pragma unroll
                for (int mm = 0; mm < 2; ++mm) { const int m = 2 * hb + mm; const int row = EPI_ROW(ai, m);
                EPI_BJ_BEGIN
#pragma unroll
                    for (int j = 0; j < 8; ++j) v[j] *= sc[m];
                    if (bj == 0 ? r0 : r1) rope8<32>(v, true, fq < 2, cs[mm]);
                    *(u32x4*)(QM + (size_t)row * 768 + c8) = pack8(v);
                EPI_BJ_END
                }
                EPI_FENCE();
            }
        EPI_HALF_END
    }
};
struct Epi2b {
    static constexpr bool PERM = true, AFTER_DRAIN = false, CHAIN = false;
    bf16_t *KN, *VM; const float* SSKV;
    __device__ __forceinline__ void operator()(f32x4 (&acc)[2][2][4][2], const Unit& u, int wr, int wc, int fr, int fq) const {
        float sc[2][4];
        {   f32x4 t[2][4][2]; bool nw[2][4];
#pragma unroll
            for (int ai = 0; ai < 2; ++ai)
#pragma unroll
                for (int m = 0; m < 4; ++m) { const int row = EPI_ROW(ai, m); int trow = row; bool isnew = true;
                    if (row >= MP) { const int s = row - MP, b = s / TS, t_ = s - b * TS; isnew = t_ >= PAST; trow = isnew ? MP + b * 64 + (t_ - PAST) : 0; }
                    const f32x4* p = (const f32x4*)(SSKV + (size_t)trow * 8); t[ai][m][0] = p[0]; t[ai][m][1] = p[1]; nw[ai][m] = isnew; }
#pragma unroll
            for (int ai = 0; ai < 2; ++ai)
#pragma unroll
                for (int m = 0; m < 4; ++m) { const f32x4 s4 = t[ai][m][0] + t[ai][m][1]; sc[ai][m] = nw[ai][m] ? rsqrtf(((s4[0] + s4[1]) + (s4[2] + s4[3])) * (1.0f / 256.0f) + RMS_EPS) : 1.0f; } }
        EPI_FENCE();
        EPI_HALF_BEGIN EPI_M_BEGIN
        EPI_BJ_BEGIN
#pragma unroll
            for (int j = 0; j < 8; ++j) v[j] *= sc[ai][m];
            if (u.pn < 2) *(u32x4*)(KN + (size_t)row * 512 + c8) = pack8(v);
            else *(u32x4*)(VM + (size_t)row * 512 + (c8 - 512)) = pack8(v);
        EPI_BJ_END EPI_M_END EPI_HALF_END
    }
};
struct Epi3 {
    static constexpr bool PERM = true, AFTER_DRAIN = false, CHAIN = true;
    const bf16_t* G; bf16_t* MM;
    __device__ __forceinline__ void operator()(f32x4 (&acc)[2][2][4][2], const Unit& u, int wr, int wc, int fr, int fq) const {
        if (u.src == 0) {
            EPI_HALF_BEGIN
                u32x4 ga[4][2], gb[4][2];
#pragma unroll
                for (int m = 0; m < 4; ++m)
#pragma unroll
                    for (int bj = 0; bj < 2; ++bj) { const bf16_t* p = G + (size_t)EPI_ROW(ai, m) * 2048 + u.pn * 256 + bj * 128 + wc * 32 + fq * 8; ga[m][bj] = *(const u32x4*)p; gb[m][bj] = *(const u32x4*)(p + 1024); }
                EPI_FENCE();
#pragma unroll
                for (int m = 0; m < 4; ++m)
#pragma unroll
                    for (int bj = 0; bj < 2; ++bj) { float a[8], b[8]; unpack8(ga[m][bj], a); unpack8(gb[m][bj], b);
#pragma unroll
                        for (int j = 0; j < 8; ++j) acc[ai][bj][m][j >> 2][j & 3] *= a[j] * __builtin_amdgcn_rcpf(b[j]); }
            EPI_HALF_END
        } else {
            u32x4 gb[2][4][2];
#pragma unroll
            for (int ai = 0; ai < 2; ++ai)
#pragma unroll
                for (int m = 0; m < 4; ++m)
#pragma unroll
                    for (int bj = 0; bj < 2; ++bj) gb[ai][m][bj] = *(const u32x4*)(G + (size_t)EPI_ROW(ai, m) * 2048 + 1024 + u.pn * 256 + bj * 128 + wc * 32 + fq * 8);
            EPI_FENCE();
            EPI_HALF_BEGIN EPI_M_BEGIN
            EPI_BJ_BEGIN float b[8]; unpack8(gb[ai][m][bj], b);
#pragma unroll
                for (int j = 0; j < 8; ++j) v[j] *= b[j];
                *(u32x4*)(MM + (size_t)row * 1024 + c8) = pack8(v);
            EPI_BJ_END EPI_M_END EPI_HALF_END
        }
    }
};
struct Epi4 {
    static constexpr bool PERM = true, AFTER_DRAIN = false, CHAIN = false;
    const float *xp, *xs; float* Y; float* SSY;
    __device__ __forceinline__ void operator()(f32x4 (&acc)[2][2][4][2], const Unit& u, int wr, int wc, int fr, int fq) const {
        EPI_HALF_BEGIN
            f32x4 xv[4][2][2];
#pragma unroll
            for (int m = 0; m < 4; ++m) { const int row = EPI_ROW(ai, m); const float* xr = (row < MP ? xp + (size_t)row * 1024 : xs + (size_t)(row - MP) * 1024) + u.pn * 256 + wc * 32 + fq * 8;
#pragma unroll
                for (int bj = 0; bj < 2; ++bj) { xv[m][bj][0] = *(const f32x4*)(xr + bj * 128); xv[m][bj][1] = *(const f32x4*)(xr + bj * 128 + 4); } }
            EPI_FENCE();
            EPI_M_BEGIN
            EPI_BJ_BEGIN float ss = 0.f;
#pragma unroll
                for (int j = 0; j < 8; ++j) { v[j] += xv[m][bj][j >> 2][j & 3]; ss += v[j] * v[j]; }
                ss += __shfl_xor(ss, 16); ss += __shfl_xor(ss, 32);
                if (fq == 0) SSY[(size_t)row * 32 + u.pn * 8 + bj * 4 + wc] = ss;
                st8f(Y + (size_t)row * 1024 + c8, v);
            EPI_BJ_END
            EPI_M_END
            EPI_FENCE();
        EPI_HALF_END
    }
};

struct SchedGrid {
    pg8::StaticOrder so; int nt;
    __device__ __forceinline__ bool next(int i, Unit& u) const { if (!so.next(i, u)) return false; u.src = 0; u.nt = nt; return true; }
    __device__ __forceinline__ void a_ready(const Unit&) const {}
    __device__ __forceinline__ void done(const Unit&) const {}
};
struct SchedP2 {
    int G, c;
    static constexpr int NA = (MT / 256) * 3, NBU = (KR / 256) * 4;
    __device__ __forceinline__ bool next(int i, Unit& u) const {
        const int j = i * G + c; if (j >= NA + NBU) return false;
        if (j < NA) { u.pm = j / 3; u.pn = j % 3; u.src = 0; u.nt = 6; } else { const int k = j - NA; u.pm = k >> 2; u.pn = k & 3; u.src = 1; u.nt = 4; }
        return true; }
    __device__ __forceinline__ void a_ready(const Unit&) const {}
    __device__ __forceinline__ void done(const Unit&) const {}
};
struct SchedTwoPass {
    pg8::StaticOrder so; int nt;
    __device__ __forceinline__ bool next(int i, Unit& u) const { if (!so.next(i >> 1, u)) return false; u.src = i & 1; u.nt = nt; return true; }
    __device__ __forceinline__ void a_ready(const Unit&) const {}
    __device__ __forceinline__ void done(const Unit&) const {}
};
struct Epi2 {
    static constexpr bool PERM = true, AFTER_DRAIN = false, CHAIN = false;
    Epi2a ea; Epi2b eb;
    __device__ __forceinline__ void operator()(f32x4 (&acc)[2][2][4][2], const Unit& u, int wr, int wc, int fr, int fq) const { if (u.src == 0) ea(acc, u, wr, wc, fr, fq); else eb(acc, u, wr, wc, fr, fq); }
};

__device__ __forceinline__ int win_dst(int n) {
    if (n < 2048) return n;
    if (n < 2432) return n - 2048 + 4608;
    if (n < 2688) return n - 2432 + 5120;
    if (n < 2720) return n - 2688 + 4992;
    if (n < 3232) return n - 2720 + 2048;
    return n - 3232 + 2560;
}
__device__ __forceinline__ void transpose_item(const float* __restrict__ W, int K, int N, bf16_t* WT, int k0, int n0, int drow0, LAS float* scr, int lane) {
#pragma unroll 8
    for (int i = 0; i < 32; ++i) { const int kk = 2 * i + (lane >> 5); scr[kk * 33 + (lane & 31)] = W[(size_t)(k0 + kk) * N + n0 + (lane & 31)]; }
    asm volatile("s_waitcnt lgkmcnt(0)" ::: "memory");
    const int c = lane & 7;
#pragma unroll
    for (int j = 0; j < 4; ++j) { const int n = (lane >> 3) + 8 * j; const LAS float* s = scr + (8 * c) * 33 + n;
        u32x4 o; o.x = pk2(s[0 * 33], s[1 * 33]); o.y = pk2(s[2 * 33], s[3 * 33]); o.z = pk2(s[4 * 33], s[5 * 33]); o.w = pk2(s[6 * 33], s[7 * 33]);
        *(u32x4*)(WT + (size_t)(drow0 + n) * K + k0 + 8 * c) = o; }
    asm volatile("s_waitcnt lgkmcnt(0)" ::: "memory");
}
__device__ __forceinline__ void sincos_acc(float angf, float& c, float& s) {
    const double x = (double)angf; const double n = __builtin_rint(x * 0.63661977236758134308);
    const double r = __builtin_fma(-n, 1.5707963267948966192, x) - n * 6.123233995736766e-17; const double r2 = r * r;
    double sp = -1.0 / 1307674368000.0; sp = sp * r2 + 1.0 / 6227020800.0; sp = sp * r2 - 1.0 / 39916800.0; sp = sp * r2 + 1.0 / 362880.0; sp = sp * r2 - 1.0 / 5040.0; sp = sp * r2 + 1.0 / 120.0; sp = sp * r2 - 1.0 / 6.0; sp = sp * r2 + 1.0; sp *= r;
    double cp = 1.0 / 20922789888000.0; cp = cp * r2 - 1.0 / 87178291200.0; cp = cp * r2 + 1.0 / 479001600.0; cp = cp * r2 - 1.0 / 3628800.0; cp = cp * r2 + 1.0 / 40320.0; cp = cp * r2 - 1.0 / 720.0; cp = cp * r2 + 1.0 / 24.0; cp = cp * r2 - 0.5; cp = cp * r2 + 1.0;
    const int q = ((int)n) & 3;
    const double ss = (q == 0) ? sp : (q == 1) ? cp : (q == 2) ? -sp : -cp;
    const double cc = (q == 0) ? cp : (q == 1) ? -sp : (q == 2) ? -cp : sp;
    c = (float)cc; s = (float)ss;
}
__device__ __forceinline__ void p0_prologue(const Args& a, LAS unsigned char* lds) {
    const int tid = threadIdx.x, lane = tid & 63, wave = tid >> 6;
    const int G = gridDim.x, gw = blockIdx.x * NWAVES + wave, NGW = G * NWAVES, gt = blockIdx.x * NTHREADS + tid, NGT = G * NTHREADS;
    unsigned char* ws = a.ws;
    LAS float* scr = (LAS float*)(lds + wave * 8704);
    if (blockIdx.x == 0 && wave == 0) {
        if (lane < 16) ((unsigned*)(ws + WS_CTL))[lane] = 0u;
        const float* L = a.in[9];
        const float sa = wave_sum(L[lane] * L[64 + lane]), sb = wave_sum(L[128 + lane] * L[192 + lane]);
        if (lane == 0) ((float*)(ws + WS_LAM))[0] = expf(sa) - expf(sb) + LAM_INIT;
    }
    for (int i = gt; i < 4096 * 8; i += NGT) { const int pos = i >> 3, j = i & 7; float c, s; sincos_acc((float)pos * c_inv_da[j], c, s); ((f32x2*)(ws + WS_ROPE_DA))[i] = (f32x2){c, s}; }
    for (int i = gt; i < 4096 * 16; i += NGT) { const int pos = i >> 4, j = i & 15; float c, s; sincos_acc((float)pos * c_inv_ml[j], c, s); ((f32x2*)(ws + WS_ROPE_ML))[i] = (f32x2){c, s}; }
    constexpr int I_IN = 16 * 165, I_UQ = 6 * 24, I_UK = 4 * 16, I_UV = 4 * 16, I_A = 8 * 32, I_B = 8 * 32, I_O = 16 * 32;
    constexpr int NITEMS = I_IN + I_UQ + I_UK + I_UV + I_A + I_B + I_O;
    for (int it = gw; it < NITEMS; it += NGW) {
        int r = it;
        if (r < I_IN) { const int kb = r / 165, nb = r % 165; transpose_item(a.in[7], 1024, 5280, (bf16_t*)(ws + WS_WIN), kb * 64, nb * 32, win_dst(nb * 32), scr, lane); continue; } r -= I_IN;
        if (r < I_UQ) { const int kb = r / 24, nb = r % 24; transpose_item(a.in[13], 384, 768, (bf16_t*)(ws + WS_WUQ), kb * 64, nb * 32, nb * 32, scr, lane); continue; } r -= I_UQ;
        if (r < I_UK) { const int kb = r / 16, nb = r % 16; transpose_item(a.in[14], 384, 512, (bf16_t*)(ws + WS_WUKV), kb * 64, nb * 32, nb * 32, scr, lane); continue; } r -= I_UK;
        if (r < I_UV) { const int kb = r / 16, nb = r % 16; transpose_item(a.in[15], 384, 512, (bf16_t*)(ws + WS_WUKV), kb * 64, nb * 32, 512 + nb * 32, scr, lane); continue; } r -= I_UV;
        if (r < I_A) { const int kb = r / 32, nb = r % 32; transpose_item(a.in[16], 512, 1024, (bf16_t*)(ws + WS_WA), kb * 64, nb * 32, nb * 32, scr, lane); continue; } r -= I_A;
        if (r < I_B) { const int kb = r / 32, nb = r % 32; transpose_item(a.in[17], 512, 1024, (bf16_t*)(ws + WS_WB), kb * 64, nb * 32, nb * 32, scr, lane); continue; } r -= I_B;
        { const int kb = r / 32, nb = r % 32; transpose_item(a.in[18], 1024, 1024, (bf16_t*)(ws + WS_WOUT), kb * 64, nb * 32, nb * 32, scr, lane); }
    }
    { u32x4* z = (u32x4*)((bf16_t*)(ws + WS_WIN) + (size_t)5024 * 1024); for (int i = gt; i < 96 * 1024 / 8; i += NGT) z[i] = (u32x4){0u, 0u, 0u, 0u}; }
    {
        const float* gp = a.in[6]; f32x4 g[4];
#pragma unroll
        for (int j = 0; j < 4; ++j) g[j] = ((const f32x4*)gp)[lane + 64 * j];
        for (int m = gw; m < MT; m += NGW) {
            const float* xr = m < MP ? a.in[0] + (size_t)m * 1024 : a.in[1] + (size_t)(m - MP) * 1024;
            f32x4 v[4]; float s = 0.f;
#pragma unroll
            for (int j = 0; j < 4; ++j) { v[j] = ((const f32x4*)xr)[lane + 64 * j]; s += (v[j][0] * v[j][0] + v[j][1] * v[j][1]) + (v[j][2] * v[j][2] + v[j][3] * v[j][3]); }
            const float rstd = rsqrtf(wave_sum(s) * (1.0f / 1024.0f) + RMS_EPS);
            u32x2* o = (u32x2*)((bf16_t*)(ws + WS_XN) + (size_t)m * 1024);
#pragma unroll
            for (int j = 0; j < 4; ++j) { u32x2 w; w.x = pk2(v[j][0] * rstd * g[j][0], v[j][1] * rstd * g[j][1]); w.y = pk2(v[j][2] * rstd * g[j][2], v[j][3] * rstd * g[j][3]); o[lane + 64 * j] = w; }
        }
    }
    for (int i = gt; i < DECB * PAST * 512 / 4; i += NGT) {
        const int e = i * 4, bt = e >> 9, c = e & 511, b = bt >> 10, t = bt & 1023; const size_t d = (size_t)(MP + b * TS + t) * 512 + c;
        const f32x4 k = ((const f32x4*)a.in[2])[i], v = ((const f32x4*)a.in[3])[i];
        *(u32x2*)((bf16_t*)(ws + WS_KA) + d) = (u32x2){pk2(k[0], k[1]), pk2(k[2], k[3])};
        *(u32x2*)((bf16_t*)(ws + WS_VA) + d) = (u32x2){pk2(v[0], v[1]), pk2(v[2], v[3])};
    }
    for (int i = gt; i < DECB * PAST * 256 / 4; i += NGT) {
        const int e = i * 4, bt = e >> 8, c = e & 255, b = bt >> 10, t = bt & 1023; const size_t d = (size_t)(MP + b * TS + t) * 384 + c;
        const f32x4 k = ((const f32x4*)a.in[4])[i];
        *(u32x2*)((bf16_t*)(ws + WS_CALL) + d) = (u32x2){pk2(k[0], k[1]), pk2(k[2], k[3])};
    }
    for (int i = gt; i < DECB * PAST * 32 / 4; i += NGT) {
        const int e = i * 4, bt = e >> 5, c = e & 31, b = bt >> 10, t = bt & 1023; const size_t d = (size_t)(MP + b * TS + t) * 32 + c;
        const f32x4 k = ((const f32x4*)a.in[5])[i];
        *(u32x2*)((bf16_t*)(ws + WS_KR) + d) = (u32x2){pk2(k[0], k[1]), pk2(k[2], k[3])};
    }
}

constexpr int A_SLOT = 16384;
constexpr int A_K = 0, A_V = 3 * A_SLOT, A_X = 0, A_WS = 6 * A_SLOT;
constexpr float A_THR = 8.0f;
#define MFMA32(a, b, c) __builtin_amdgcn_mfma_f32_32x32x16_bf16(a, b, c, 0, 0, 0)
#define SBAR() __builtin_amdgcn_sched_barrier(0)
#define PIN(x) asm volatile("" : "+v"(x))
typedef short v4i16_t __attribute__((ext_vector_type(4)));
__device__ __forceinline__ s16x4 vtr(const LAS unsigned char* p) { return __builtin_bit_cast(s16x4, __builtin_amdgcn_ds_read_tr16_b64_v4i16((LAS v4i16_t*)p)); }
__device__ __forceinline__ bf16x8 vfrag(const LAS unsigned char* p) { const s16x4 lo = vtr(p), hh = vtr(p + 512); return (bf16x8){lo[0], lo[1], lo[2], lo[3], hh[0], hh[1], hh[2], hh[3]}; }
__device__ __forceinline__ float max3f(float a, float b, float c) { return __builtin_fmaxf(__builtin_fmaxf(a, b), c); }

__device__ __forceinline__ void glds16(const void* g, unsigned lds_base) {
    unsigned sv; asm volatile("s_mov_b32 %0, m0\n\ts_mov_b32 m0, %2\n\ts_nop 0\n\tglobal_load_lds_dwordx4 %1, off\n\ts_mov_b32 m0, %0" : "=&s"(sv) : "v"(g), "s"(lds_base) : "memory"); }
#define ATT_WAIT_BAR() asm volatile("s_waitcnt vmcnt(0) lgkmcnt(0)\n\ts_barrier" ::: "memory")
__device__ __forceinline__ void att_wait_bar_n(int n) {
    if (n == 0) asm volatile("s_waitcnt vmcnt(0) lgkmcnt(0)\n\ts_barrier" ::: "memory");
    else if (n == 1) asm volatile("s_waitcnt vmcnt(1) lgkmcnt(0)\n\ts_barrier" ::: "memory");
    else if (n == 2) asm volatile("s_waitcnt vmcnt(2) lgkmcnt(0)\n\ts_barrier" ::: "memory");
    else if (n == 3) asm volatile("s_waitcnt vmcnt(3) lgkmcnt(0)\n\ts_barrier" ::: "memory");
    else asm volatile("s_waitcnt vmcnt(4) lgkmcnt(0)\n\ts_barrier" ::: "memory");
}
struct AUnit { int qrow0, kbase, nt, nrow, h; };

template <int ND0, int NDB, bool GQK, bool GPV>
__device__ __forceinline__ void attn_step(bf16x8 (&kf)[2 * ND0], const bf16x8 (&qr)[ND0], f32x16& C0, f32x16& C1, const f32x16& P0, const f32x16& P1, f32x16 (&o)[NDB],
                                          float& mrow, float& lrow, bool& resc, LAS float* wsf, const LAS unsigned char* kn, const LAS unsigned char* vb, int r32, int hi, bool upd = true) {
    constexpr int NQ = GQK ? 2 * ND0 : 0, NP = GPV ? 4 * NDB : 0, NG = NQ + NP, LA = 3, EPG = GPV ? 32 / (4 * NDB) : 32;
    bf16x8 vf[4]; u32x4 pw[4]; float sacc = 0.f;
    resc = false;
    if constexpr (GPV && !GQK) {
#pragma unroll
        for (int u = 0; u < 8; ++u) { const f32x16& S = u < 4 ? P0 : P1; const int b = (u & 3) * 4;
            sacc += (S[b] + S[b + 1]) + (S[b + 2] + S[b + 3]); pw[u >> 1][(u & 1) * 2] = pk2(S[b], S[b + 1]); pw[u >> 1][(u & 1) * 2 + 1] = pk2(S[b + 2], S[b + 3]); }
    }
#pragma unroll
    for (int j = 0; j < NP; ++j) if (NQ + j - LA < 0) vf[j & 3] = vfrag(vb + (j % NDB) * 4096 + (j / NDB) * 1024);
    SBAR();
#pragma unroll
    for (int g = 0; g < NG; ++g) {
#pragma unroll
        for (int j = 0; j < NP; ++j) if (NQ + j - LA == g) vf[j & 3] = vfrag(vb + (j % NDB) * 4096 + (j / NDB) * 1024);
        if (g < NQ) {
            if (g < 2) { if (g & 1) C1 = MFMA32(kf[g], qr[g >> 1], f32x16{}); else C0 = MFMA32(kf[g], qr[g >> 1], f32x16{}); }
            else { if (g & 1) C1 = MFMA32(kf[g], qr[g >> 1], C1); else C0 = MFMA32(kf[g], qr[g >> 1], C0); }
            if (GPV && g < 8) { const int u = g; const f32x16& S = u < 4 ? P0 : P1; const int b = (u & 3) * 4;
                sacc += S[b]; sacc += S[b + 1]; sacc += S[b + 2]; sacc += S[b + 3]; PIN(sacc);
                pw[u >> 1][(u & 1) * 2] = pk2(S[b], S[b + 1]); pw[u >> 1][(u & 1) * 2 + 1] = pk2(S[b + 2], S[b + 3]); PIN(pw[u >> 1]); }
        } else {
            const int j = g - NQ, ks = j / NDB, d = j % NDB;
            if (GQK) {
                if (ND0 == 4) { if (j >= 4 && j < 12) kf[j - 4] = *(const LAS bf16x8*)(kn + ((j - 4) >> 1) * 2048 + ((j - 4) & 1) * 512); }
                else { if (j >= 1 && j < 7) { const int q = j - 1; kf[2 * q] = *(const LAS bf16x8*)(kn + q * 2048); kf[2 * q + 1] = *(const LAS bf16x8*)(kn + q * 2048 + 512); } }
            }
            o[d] = MFMA32(__builtin_bit_cast(bf16x8, pw[ks]), vf[j & 3], o[d]);
            if (GQK) {
#pragma unroll
                for (int e = j * EPG; e < (j + 1) * EPG; ++e) { if (e < 16) C0[e] = __builtin_amdgcn_exp2f(C0[e] - mrow); else C1[e - 16] = __builtin_amdgcn_exp2f(C1[e - 16] - mrow); }
                if ((j * EPG) < 16) PIN(C0); else PIN(C1);
            }
        }
        SBAR();
        if (GQK && g == NQ - 1) {
            if (GPV) lrow += sacc;
            float a = max3f(C0[0], C0[1], C1[0]), b = max3f(C0[2], C0[3], C1[1]); a = max3f(a, C1[2], C1[3]);
#pragma unroll
            for (int r = 4; r < 16; r += 4) { a = max3f(a, C0[r], C0[r + 1]); b = max3f(b, C0[r + 2], C0[r + 3]); a = max3f(a, C1[r], C1[r + 1]); b = max3f(b, C1[r + 2], C1[r + 3]); }
            float rm = __builtin_fmaxf(a, b); rm = __builtin_fmaxf(rm, __shfl_xor(rm, 32));
            if (!GPV) mrow = rm;
            else if (upd && __builtin_expect(__any(rm > mrow + A_THR), 0)) {
                const float mn = __builtin_fmaxf(mrow, rm), f = __builtin_amdgcn_exp2f(mrow - mn); mrow = mn; lrow *= f;
                if (hi == 0) wsf[r32] = f;
                resc = true;
            }
            SBAR();
        }
    }
    if constexpr (GQK && !GPV) {
#pragma unroll
        for (int r = 0; r < 16; ++r) { C0[r] = __builtin_amdgcn_exp2f(C0[r] - mrow); C1[r] = __builtin_amdgcn_exp2f(C1[r] - mrow); }
#pragma unroll
        for (int i = 0; i < 2 * ND0; ++i) kf[i] = *(const LAS bf16x8*)(kn + (i >> 1) * 2048 + (i & 1) * 512);
    }
    if constexpr (GPV && !GQK) lrow += sacc;
}

template <bool DA>
__device__ __forceinline__ void attn_unit(LAS unsigned char* lds, const AUnit U, const Args& a) {
    constexpr int DQK = DA ? 64 : 96, DV = DA ? 128 : 64, ND0 = DQK / 16, NDB = DV / 32;
    const int tid = threadIdx.x, lane = tid & 63, r32 = lane & 31, hi = lane >> 5; const int wid = __builtin_amdgcn_readfirstlane(tid >> 6);
    unsigned char* ws = a.ws;
    const int wq = DA ? (wid & 3) : wid, comp = DA ? (wid >> 2) : 0;
    const int wrow = wq * 32; const bool active = wrow < U.nrow;
    const int myrow0 = U.qrow0 + wrow;
    const int my_nt = active ? (tok_pos(myrow0) >> 6) + 1 : 0;
    bf16x8 qr[ND0];
    {
        const bf16_t* Qb = DA ? (const bf16_t*)(ws + WS_QA) + (size_t)(myrow0 + r32) * 512 + U.h * 128 + comp * 64 : (const bf16_t*)(ws + WS_QM) + (size_t)(myrow0 + r32) * 768 + U.h * 96;
#pragma unroll
        for (int d0 = 0; d0 < ND0; ++d0) qr[d0] = active ? *(const bf16x8*)(Qb + d0 * 16 + hi * 8) : (bf16x8){0, 0, 0, 0, 0, 0, 0, 0};
    }
    const bf16_t *ksrc0, *ksrc1, *vsrc0, *vsrc1; size_t kst0, kst1;
    const int vrow = 16 * (wid & 3) + (lane >> 2), vsub = (lane & 3) * 8;
    if (DA) {
        ksrc0 = (const bf16_t*)(ws + WS_KA) + (size_t)(U.kbase + lane) * 512 + U.h * 128 + wid * 8; ksrc1 = ksrc0 + 64; kst0 = kst1 = 64 * 512;
        vsrc0 = (const bf16_t*)(ws + WS_VA) + (size_t)(U.kbase + vrow) * 512 + U.h * 128 + (wid >> 2) * 32 + vsub; vsrc1 = vsrc0 + 64;
    } else {
        ksrc0 = (const bf16_t*)(ws + WS_KN) + (size_t)(U.kbase + lane) * 512 + U.h * 64 + wid * 8; kst0 = 64 * 512;
        ksrc1 = (const bf16_t*)(ws + WS_KR) + (size_t)(U.kbase + lane) * 32 + (wid & 3) * 8; kst1 = 64 * 32;
        vsrc0 = (const bf16_t*)(ws + WS_VM) + (size_t)(U.kbase + vrow) * 512 + U.h * 64 + (wid >> 2) * 32 + vsub; vsrc1 = vsrc0;
    }
    LAS unsigned char* const kdst = lds + A_K + wid * 1024; LAS unsigned char* const vdst = lds + A_V + wid * 1024;
#define DMA16(g, l) glds16((g), (unsigned)__builtin_amdgcn_readfirstlane((int)(unsigned)(uintptr_t)(l)))
#define DMA_K(t, slot) do { DMA16(ksrc0 + (size_t)(t) * kst0, kdst + (slot) * A_SLOT); if (DA || wid < 4) DMA16(ksrc1 + (size_t)(t) * kst1, kdst + (slot) * A_SLOT + 8192); } while (0)
#define DMA_V(t, slot) do { DMA16(vsrc0 + (size_t)(t) * 64 * 512, vdst + (slot) * A_SLOT); if (DA) DMA16(vsrc1 + (size_t)(t) * 64 * 512, vdst + (slot) * A_SLOT + 8192); } while (0)
    LAS float* wsf = (LAS float*)(lds + A_WS) + wid * 64;
    const LAS unsigned char* const kp0 = lds + A_K + hi * 1024 + r32 * 16 + (DA ? comp * 8192 : 0);
    const LAS unsigned char* const vp0 = lds + A_V + ((lane >> 4) & 1) * 32 + (lane & 3) * 8 + (4 * hi + ((lane & 15) >> 2)) * 64;
    f32x16 o[NDB];
#pragma unroll
    for (int d = 0; d < NDB; ++d) o[d] = f32x16{};
    float mrow = 0.f, lrow = 0.f; bool resc = false;
    f32x16 pA0, pA1, pB0, pB1; bf16x8 kf[2 * ND0];
    pA0 = f32x16{}; pA1 = f32x16{}; pB0 = f32x16{}; pB1 = f32x16{};
    DMA_K(0, 0); DMA_K(1, 1); if (2 < U.nt) DMA_K(2, 2); DMA_V(0, 0);
#pragma unroll
    for (int d0 = 0; d0 < ND0; ++d0) PIN(qr[d0]);
    ATT_WAIT_BAR();
#pragma unroll
    for (int i = 0; i < 2 * ND0; ++i) kf[i] = *(const LAS bf16x8*)(kp0 + (i >> 1) * 2048 + (i & 1) * 512);
    ATT_WAIT_BAR();
    const int NKD = DA ? 2 : (wid < 4 ? 2 : 1), NVD = DA ? 2 : 1;
    int s0 = 0, s1 = 1, s2 = 2;
#define RESC() do { if (resc) { asm volatile("s_waitcnt lgkmcnt(0)" ::: "memory"); _Pragma("unroll") for (int r = 0; r < 16; ++r) { const float f_ = wsf[crow(r, hi)]; \
        _Pragma("unroll") for (int d = 0; d < NDB; ++d) o[d][r] *= f_; } asm volatile("s_waitcnt lgkmcnt(0)" ::: "memory"); } } while (0)
#define STEP_TOP(t) \
        int nd_ = 0; if ((t) + 3 < U.nt) { DMA_K((t) + 3, s0); nd_ += NKD; } if ((t) + 1 < U.nt) { DMA_V((t) + 1, s1); nd_ += NVD; } \
        const LAS unsigned char* kn_ = kp0 + s1 * A_SLOT; const LAS unsigned char* vb_ = vp0 + s2 * A_SLOT; resc = false;
#define STEP_END() do { att_wait_bar_n(nd_); { const int s_ = s0; s0 = s1; s1 = s2; s2 = s_; } } while (0)
#define STEP(CA, CB, PA, PB, t) do { STEP_TOP(t) \
        if ((t) <= my_nt) attn_step<ND0, NDB, true, true>(kf, qr, CA, CB, PA, PB, o, mrow, lrow, resc, wsf, kn_, vb_, r32, hi, (t) < my_nt); \
        STEP_END(); \
        RESC(); } while (0)
    { STEP_TOP(0) if (my_nt > 0) attn_step<ND0, NDB, true, false>(kf, qr, pA0, pA1, pB0, pB1, o, mrow, lrow, resc, wsf, kn_, vb_, r32, hi); STEP_END(); }
    for (int t = 1; t < U.nt; t += 2) {
        STEP(pB0, pB1, pA0, pA1, t);
        if (t + 1 < U.nt) STEP(pA0, pA1, pB0, pB1, t + 1);
    }
    if (my_nt == U.nt) {
        const LAS unsigned char* vb_ = vp0 + s2 * A_SLOT;
        if ((U.nt - 1) & 1) attn_step<ND0, NDB, false, true>(kf, qr, pA0, pA1, pB0, pB1, o, mrow, lrow, resc, wsf, kp0, vb_, r32, hi);
        else attn_step<ND0, NDB, false, true>(kf, qr, pB0, pB1, pA0, pA1, o, mrow, lrow, resc, wsf, kp0, vb_, r32, hi);
    }
#undef STEP
#undef STEP_TOP
#undef STEP_END
#undef RESC
#undef DMA_K
#undef DMA_V
#undef DMA16
    lrow += __shfl_xor(lrow, 32);
    if (hi == 0) wsf[r32] = active ? 1.0f / lrow : 0.f;
    asm volatile("s_waitcnt lgkmcnt(0)" ::: "memory");
    float il[16];
#pragma unroll
    for (int r = 0; r < 16; ++r) il[r] = wsf[crow(r, hi)];
    asm volatile("s_waitcnt lgkmcnt(0)" ::: "memory");
    if (DA) {
        LAS float* X = (LAS float*)(lds + A_X) + (size_t)wq * (NDB * 16 * 64);
        __syncthreads();
        if (comp == 1) {
#pragma unroll
            for (int d = 0; d < NDB; ++d)
#pragma unroll
                for (int r = 0; r < 16; ++r) X[(d * 16 + r) * 64 + lane] = o[d][r] * il[r];
        }
        __syncthreads();
        if (comp == 0 && active) {
            const float lam = ((const float*)(ws + WS_LAM))[0];
            float ss[16];
#pragma unroll
            for (int r = 0; r < 16; ++r) { ss[r] = 0.f;
#pragma unroll
                for (int d = 0; d < NDB; ++d) { const float x = o[d][r] * il[r] - lam * X[(d * 16 + r) * 64 + lane]; o[d][r] = x; ss[r] += x * x; } }
#pragma unroll
            for (int r = 0; r < 16; ++r) { float s = ss[r]; s += __shfl_xor(s, 1); s += __shfl_xor(s, 2); s += __shfl_xor(s, 4); s += __shfl_xor(s, 8); s += __shfl_xor(s, 16); ss[r] = rsqrtf(s * (1.0f / 128.0f) + RMS_EPS) * (1.0f - LAM_INIT); }
            const float* gh = a.in[10];
            const bf16_t* sz = (const bf16_t*)(ws + WS_SZA); bf16_t* ua = (bf16_t*)(ws + WS_UA);
#pragma unroll
            for (int d = 0; d < NDB; ++d) { const int col = U.h * 128 + d * 32 + r32; const float g = gh[d * 32 + r32];
#pragma unroll
                for (int r = 0; r < 16; ++r) { const size_t idx = (size_t)(myrow0 + crow(r, hi)) * 512 + col; ua[idx] = (bf16_t)(pk2(o[d][r] * ss[r] * g * bf2f(sz[idx]), 0.f) & 0xffffu); } }
        }
        __syncthreads();
    } else {
        if (active) {
            const bf16_t* sz = (const bf16_t*)(ws + WS_SZB); bf16_t* ub = (bf16_t*)(ws + WS_UB);
#pragma unroll
            for (int d = 0; d < NDB; ++d) { const int col = U.h * 64 + d * 32 + r32;
#pragma unroll
                for (int r = 0; r < 16; ++r) { const size_t idx = (size_t)(myrow0 + crow(r, hi)) * 512 + col; ub[idx] = (bf16_t)(pk2(o[d][r] * il[r] * bf2f(sz[idx]), 0.f) & 0xffffu); } }
        }
        __syncthreads();
    }
}
__device__ __forceinline__ void attn_phase(LAS unsigned char* lds, const Args& a, int cw) {
    const int G = gridDim.x, bid = blockIdx.x;
    if (G == 256) {
        const int xcd = bid & 7, i = bid >> 3;
        for (int s = 0; s < 17; ++s) {
            AUnit U; bool da;
            if (s < 8) { const int bh = xcd * 8 + s, b = bh >> 2, qb = (s & 1) ? 31 - i : i; da = true; U.h = bh & 3; U.qrow0 = b * SEQ + qb * 128; U.kbase = b * SEQ; U.nt = 2 * qb + 2; U.nrow = 128; }
            else if (s < 16) { const int k = s - 8, j = i & 15, bh = xcd * 16 + 2 * k + (i >> 4), b = bh >> 3, qb = (k & 1) ? 15 - j : j;
                da = false; U.h = bh & 7; U.qrow0 = b * SEQ + qb * 256; U.kbase = b * SEQ; U.nt = 4 * qb + 4; U.nrow = 256; }
            else { if (bid >= 96) break;
                if (bid < 32) { const int b = bid >> 2; da = true; U.h = bid & 3; U.qrow0 = MP + b * 64; U.kbase = MP + b * TS; U.nt = 17; U.nrow = 64; }
                else { const int jj = bid - 32, b = jj >> 3; da = false; U.h = jj & 7; U.qrow0 = MP + b * 64; U.kbase = MP + b * TS; U.nt = 17; U.nrow = 64; } }
            if (da) attn_unit<true>(lds, U, a); else attn_unit<false>(lds, U, a);
        }
        return;
    }
    unsigned* ctr = (unsigned*)(a.ws + WS_CTL) + cw;
    volatile LAS int* misc = (volatile LAS int*)(lds + LDS_MISC);
    for (;;) {
        if (threadIdx.x == 0) misc[0] = (int)atomicAdd(ctr, 1u);
        __syncthreads();
        const int it = misc[0];
        __syncthreads();
        if (it >= 4096 + 96) break;
        AUnit U; bool da;
        if (it < 4096) {
            const int r = it >> 7, j = it & 127;
            if (j < 64) { const int b = j >> 2, qb = 31 - r; da = true; U.h = j & 3; U.qrow0 = b * SEQ + qb * 128; U.kbase = b * SEQ; U.nt = 2 * qb + 2; U.nrow = 128; }
            else { const int bh = 2 * (j - 64) + (r & 1), b = bh >> 3, qb = 15 - (r >> 1); da = false; U.h = bh & 7; U.qrow0 = b * SEQ + qb * 256; U.kbase = b * SEQ; U.nt = 4 * qb + 4; U.nrow = 256; }
        } else { const int q = it - 4096;
            if (q < 32) { const int b = q >> 2; da = true; U.h = q & 3; U.qrow0 = MP + b * 64; U.kbase = MP + b * TS; U.nt = 17; U.nrow = 64; }
            else { const int jj = q - 32, b = jj >> 3; da = false; U.h = jj & 7; U.qrow0 = MP + b * 64; U.kbase = MP + b * TS; U.nt = 17; U.nrow = 64; } }
        if (da) attn_unit<true>(lds, U, a); else attn_unit<false>(lds, U, a);
    }
}

__global__ void __launch_bounds__(NTHREADS, 2) mega_fwd(Args a) {
    extern __shared__ __attribute__((aligned(16))) unsigned char lds_raw[];
    LAS unsigned char* lds = (LAS unsigned char*)lds_raw;
    cg::grid_group grid = cg::this_grid();
    unsigned char* ws = a.ws; float* out = a.out;
    const int G = gridDim.x, bid = blockIdx.x, tid = threadIdx.x, lane = tid & 63, wave = tid >> 6;
    const int lo = a.ph_lo, hi = a.ph_hi;
#define IN(k) (lo <= (k) && (k) < hi)
#define SEAM(k) do { if (IN(k) && IN((k) + 1)) grid.sync(); } while (0)
    const f32x2* cs_da = (const f32x2*)(ws + WS_ROPE_DA); const f32x2* cs_ml = (const f32x2*)(ws + WS_ROPE_ML);
    if (IN(0)) { p0_prologue(a, lds); if (PROBE_REP == 0) { __syncthreads(); p0_prologue(a, lds); } }
    SEAM(0);
    if (IN(1)) {
        Epi1 E{ws, out, a.in[8], a.in[11], a.in[12]};
        pg8::Gemm g{(const bf16_t*)(ws + WS_XN), nullptr, (const bf16_t*)(ws + WS_WIN), nullptr, 1024};
        SchedGrid S; S.so.init(MT, NIN, G, bid); S.nt = 16;
        for (int rep = 0; rep < (PROBE_REP == 1 ? 2 : 1); ++rep)
        pg8::gemm_phase<Epi1, SchedGrid, true, true>(lds, g, S, E);
    }
    SEAM(1);
    if (IN(2)) {
        Epi2a Ea{(bf16_t*)(ws + WS_QM), (const float*)(ws + WS_SSQ), cs_ml};
        Epi2b Eb{(bf16_t*)(ws + WS_KN), (bf16_t*)(ws + WS_VM), (const float*)(ws + WS_SSKV)};
        pg8::Gemm g{(const bf16_t*)(ws + WS_CQ), (const bf16_t*)(ws + WS_CALL), (const bf16_t*)(ws + WS_WUQ), (const bf16_t*)(ws + WS_WUKV), 384};
        SchedP2 S{G, bid}; Epi2 E{Ea, Eb};
        for (int rep = 0; rep < (PROBE_REP == 2 ? 2 : 1); ++rep)
        pg8::gemm_phase<Epi2, SchedP2, true, true>(lds, g, S, E);
        for (int m = bid * NWAVES + wave; m < MT; m += G * NWAVES) {
            const float* p = (const float*)(ws + WS_SSKV) + (size_t)m * 8; float s = 0.f;
#pragma unroll
            for (int j = 0; j < 8; ++j) s += p[j];
            const float rstd = rsqrtf(s * (1.0f / 256.0f) + RMS_EPS);
            f32x4* r = (f32x4*)(m < MP ? out + O_LP + (size_t)m * 256 : out + O_LS + (size_t)(m - MP) * 256) + lane;
            f32x4 v = *r; v = v * rstd; *r = v;
        }
    }
    SEAM(2);
    if (IN(3)) { attn_phase(lds, a, 0); if (PROBE_REP == 3) { __syncthreads(); attn_phase(lds, a, 1); } }
    SEAM(3);
    if (IN(4)) {
        pg8::Gemm g{(const bf16_t*)(ws + WS_UA), (const bf16_t*)(ws + WS_UB), (const bf16_t*)(ws + WS_WA), (const bf16_t*)(ws + WS_WB), 512};
        SchedTwoPass S; S.so.init(MT, 1024, G, bid); S.nt = 8; Epi3 E{(const bf16_t*)(out + O_Y), (bf16_t*)(ws + WS_MM)};
        for (int rep = 0; rep < (PROBE_REP == 4 ? 2 : 1); ++rep)
        pg8::gemm_phase<Epi3, SchedTwoPass, true, true>(lds, g, S, E);
    }
    SEAM(4);
    if (IN(5)) {
        Epi4 E{a.in[0], a.in[1], out + O_Y, (float*)(ws + WS_SSY)};
        pg8::Gemm g{(const bf16_t*)(ws + WS_MM), nullptr, (const bf16_t*)(ws + WS_WOUT), nullptr, 1024};
        SchedGrid S; S.so.init(MT, 1024, G, bid); S.nt = 16;
        for (int rep = 0; rep < (PROBE_REP == 5 ? 2 : 1); ++rep)
        pg8::gemm_phase<Epi4, SchedGrid, true, true>(lds, g, S, E);
    }
    SEAM(5);
    if (IN(6)) {
        f32x4 g[4];
#pragma unroll
        for (int j = 0; j < 4; ++j) g[j] = ((const f32x4*)a.in[19])[lane + 64 * j];
        for (int m = bid * NWAVES + wave; m < MT; m += G * NWAVES) {
            const float* p = (const float*)(ws + WS_SSY) + (size_t)m * 32;
            const float s = wave_sum(lane < 32 ? p[lane] : 0.f);
            const float rstd = rsqrtf(s * (1.0f / 1024.0f) + RMS_EPS);
            f32x4* r = (f32x4*)(out + O_Y + (size_t)m * 1024);
#pragma unroll
            for (int j = 0; j < 4; ++j) { f32x4 v = r[lane + 64 * j]; v = v * rstd * g[j]; r[lane + 64 * j] = v; }
        }
    }
#undef IN
#undef SEAM
}

extern "C" void kernel_launch(void* const* d_in, const int* in_sizes, int n_in, void* d_out, int out_size, void* d_ws, size_t ws_size, hipStream_t stream) {
    static int grid = 0;
    if (grid == 0) {
        if (n_in != 20 || (size_t)out_size != O_END || ws_size < WS_END) { fprintf(stderr, "kernel_launch: unexpected shapes (n_in %d out %d ws %zu)\n", n_in, out_size, ws_size); grid = -1; return; }
        int dev = 0, cus = 0, per_cu = 0;
        hipGetDevice(&dev); hipDeviceGetAttribute(&cus, hipDeviceAttributeMultiprocessorCount, dev);
        if (hipFuncSetAttribute((const void*)mega_fwd, hipFuncAttributeMaxDynamicSharedMemorySize, LDS_BYTES) != hipSuccess) { fprintf(stderr, "kernel_launch: hipFuncSetAttribute failed\n"); grid = -1; return; }
        if (hipOccupancyMaxActiveBlocksPerMultiprocessor(&per_cu, (const void*)mega_fwd, NTHREADS, LDS_BYTES) != hipSuccess || per_cu < 1) { fprintf(stderr, "kernel_launch: occupancy query says %d\n", per_cu); (void)hipGetLastError(); grid = -1; return; }
        grid = cus;
        if (grid > cus * per_cu) grid = cus * per_cu;
    }
    if (grid < 0) return;
    Args a{};
    for (int i = 0; i < 20; ++i) a.in[i] = (const float*)d_in[i];
    a.out = (float*)d_out; a.ws = (unsigned char*)d_ws;
#if MK_N_LAUNCHES == 1
    a.ph_lo = 0; a.ph_hi = 7;
    void* args[] = {&a};
    hipError_t e = hipLaunchCooperativeKernel((const void*)mega_fwd, dim3(grid), dim3(NTHREADS), args, LDS_BYTES, stream);
    if (e != hipSuccess) fprintf(stderr, "cooperative launch failed: %s (grid %d)\n", hipGetErrorString(e), grid);
#else
    for (int p = 0; p < 7; ++p) { a.ph_lo = p; a.ph_hi = p + 1; hipLaunchKernelGGL(mega_fwd, dim3(grid), dim3(NTHREADS), LDS_BYTES, stream, a); }
#endif
}
```
